# Optimizing an MI355X kernel written in HIP

```python
import jax, jax.numpy as jnp
from jax import lax
import numpy as np

D_MODEL = 2048
BATCH = 2
SEQ = 8192
DEPTH = 4
DEC_BATCH = 2
DEC_SEQ = 4096
PAST_LEN = 128

MIX_WIDTH = D_MODEL
RWKV_WIDTH = MIX_WIDTH // 2
POOL_WIDTH = MIX_WIDTH - RWKV_WIDTH
HEAD_DIM = 64
N_HEADS = RWKV_WIDTH // HEAD_DIM
DECAY_RANK = 64
ICLR_RANK = 64
GATE_RANK = 160
POOL_WINDOWS = (2, 4, 8, 16)
N_POOL_GROUPS = len(POOL_WINDOWS)
POOL_GROUP_WIDTH = POOL_WIDTH // N_POOL_GROUPS
D_FF = 4 * D_MODEL
N_DIR = 2
N_MOD = 6
NORM_EPS = 1e-6
GN_EPS = 64e-5

_R0 = 0
_K0 = RWKV_WIDTH
_V0 = 2 * RWKV_WIDTH
_WD0 = 3 * RWKV_WIDTH
_AD0 = _WD0 + N_DIR * DECAY_RANK
_GD0 = _AD0 + N_DIR * ICLR_RANK
_P0 = _GD0 + GATE_RANK
IN_COLS = _P0 + POOL_WIDTH

kernel_name = 'hymba_rwkv7_pool_adaln_encoder'


def rms_norm(x, g):
    x32 = x.astype(jnp.float32)
    y = x32 * lax.rsqrt(jnp.mean(x32 * x32, axis=-1, keepdims=True) + NORM_EPS)
    return (y * g.astype(jnp.float32)).astype(x.dtype)


def modulate(h, shift, scale):
    return h * (1.0 + scale[:, None, :]) + shift[:, None, :]


def wkv7_bidirectional(r, w, k, v, kk, b):
    B, T = r.shape[0], r.shape[1]

    def to_time_major(z):
        z = z.reshape(B, T, N_DIR, N_HEADS, HEAD_DIM)
        z = jnp.stack([z[:, :, 0], z[:, ::-1, 1]], axis=0)
        return jnp.transpose(z, (2, 0, 1, 3, 4))

    def step(S, inp):
        r_t, w_t, k_t, v_t, kk_t, b_t = inp
        sa = jnp.einsum('dbhvk,dbhk->dbhv', S, kk_t)
        S = S * w_t[..., None, :] - sa[..., None] * b_t[..., None, :] + v_t[..., None] * k_t[..., None, :]
        y = jnp.einsum('dbhvk,dbhk->dbhv', S, r_t)
        return S, y

    S0 = jnp.zeros((N_DIR, B, N_HEADS, HEAD_DIM, HEAD_DIM), jnp.float32)
    xs = (to_time_major(r), to_time_major(w), to_time_major(k),
          to_time_major(v), to_time_major(kk), to_time_major(b))
    _, y = lax.scan(step, S0, xs)
    y_fwd = jnp.transpose(y[:, 0], (1, 0, 2, 3))
    y_bwd = jnp.transpose(y[::-1, 1], (1, 0, 2, 3))
    return y_fwd + y_bwd


def rwkv7_mixer(p, w0, w2, a0, a2, g2, k_k, k_a, r_k, lnx_w, lnx_b):
    B, T = p.shape[0], p.shape[1]
    r = p[..., _R0:_R0 + RWKV_WIDTH]
    k = p[..., _K0:_K0 + RWKV_WIDTH]
    v = p[..., _V0:_V0 + RWKV_WIDTH]
    xw = p[..., _WD0:_AD0].reshape(B, T, N_DIR, DECAY_RANK)
    xa = p[..., _AD0:_GD0].reshape(B, T, N_DIR, ICLR_RANK)
    xg = p[..., _GD0:_P0]
    w_log = -jax.nn.softplus(-(w0 + jnp.einsum('btdr,drc->btdc', jnp.tanh(xw), w2))) - 0.5
    decay = jnp.exp(-jnp.exp(w_log))
    a = jax.nn.sigmoid(a0 + jnp.einsum('btdr,drc->btdc', xa, a2))
    g = jnp.einsum('btr,rc->btc', jax.nn.sigmoid(xg), g2)
    kk = (k * k_k).reshape(B, T, N_HEADS, HEAD_DIM)
    kk = kk * lax.rsqrt(jnp.maximum(jnp.sum(kk * kk, axis=-1, keepdims=True), 1e-24))
    kk = kk.reshape(B, T, RWKV_WIDTH)
    k_dir = k[:, :, None, :] * (1.0 + (a - 1.0) * k_a)
    b_dir = kk[:, :, None, :] * a
    both = lambda z: jnp.broadcast_to(z[:, :, None, :], (B, T, N_DIR, RWKV_WIDTH))
    y = wkv7_bidirectional(both(r), decay, k_dir, both(v), both(kk), b_dir)
    mu = jnp.mean(y, axis=-1, keepdims=True)
    var = jnp.mean(jnp.square(y - mu), axis=-1, keepdims=True)
    gn = ((y - mu) * lax.rsqrt(var + GN_EPS)).reshape(B, T, RWKV_WIDTH) * lnx_w + lnx_b
    rk = (r[:, :, None, :] * k_dir).reshape(B, T, N_DIR, N_HEADS, HEAD_DIM) * r_k
    bonus = jnp.sum(rk, axis=(2, 4))[..., None] * v.reshape(B, T, N_HEADS, HEAD_DIM)
    return (gn + bonus.reshape(B, T, RWKV_WIDTH)) * g


def pool_mixer(p, pool_w, pool_scale):
    B, T = p.shape[0], p.shape[1]
    u = p[..., _P0:_P0 + POOL_WIDTH].reshape(B, T, N_POOL_GROUPS, POOL_GROUP_WIDTH)
    cs = jnp.concatenate([jnp.zeros((B, 1, N_POOL_GROUPS, POOL_GROUP_WIDTH), jnp.float32),
                          jnp.cumsum(u, axis=1)], axis=1)
    t = jnp.arange(T)
    pooled = []
    for gi, win in enumerate(POOL_WINDOWS):
        lo = jnp.clip(t - win // 2, 0, T)
        hi = jnp.clip(t + win // 2, 0, T)
        cg = cs[:, :, gi]
        s = jnp.take(cg, hi, axis=1) - jnp.take(cg, lo, axis=1)
        pooled.append(s / (hi - lo).astype(jnp.float32)[None, :, None])
    pooled = jnp.stack(pooled, axis=2) - u
    mixed = jnp.einsum('btgc,gcd->btgd', pooled, pool_w.astype(jnp.float32))
    return mixed.reshape(B, T, POOL_WIDTH) * pool_scale


def trunk(x, c, ada_w, ada_b, norm1_g, w_in, w0, w2, a0, a2, g2, k_k, k_a, r_k,
          lnx_w, lnx_b, pool_w, pool_scale, w_out, norm2_g, mlp_w1, mlp_w2, final_g):
    for l in range(DEPTH):
        mod = jax.nn.silu(c) @ ada_w[l] + ada_b[l]
        sh1, sc1, gt1, sh2, sc2, gt2 = jnp.split(mod, N_MOD, axis=-1)
        h = modulate(rms_norm(x, norm1_g[l]), sh1, sc1)
        p = (h @ w_in[l]).astype(jnp.float32)
        mix_a = rwkv7_mixer(p, w0[l], w2[l], a0[l], a2[l], g2[l], k_k[l], k_a[l], r_k[l],
                            lnx_w[l], lnx_b[l])
        mix_b = pool_mixer(p, pool_w[l], pool_scale[l])
        mix = jnp.concatenate([mix_a, mix_b], axis=-1).astype(x.dtype)
        x = x + gt1[:, None, :] * (mix @ w_out[l])
        h = modulate(rms_norm(x, norm2_g[l]), sh2, sc2)
        f = jnp.square(jax.nn.relu(h @ mlp_w1[l])) @ mlp_w2[l]
        x = x + gt2[:, None, :] * f
    return rms_norm(x, final_g)


def setup_inputs(seed: int = 0) -> dict:
    key = jax.random.key(seed)
    ks = jax.random.split(key, 32)
    f32 = jnp.float32
    nrm = lambda k, shape, s: jax.random.normal(k, shape, f32) * s
    base_decay = -7.0 + 5.0 * (jnp.arange(RWKV_WIDTH, dtype=f32) / (RWKV_WIDTH - 1)) ** 0.85 + 0.5
    return {
        'x_prompt': nrm(ks[0], (BATCH, SEQ, D_MODEL), 1.0),
        'x_sample': nrm(ks[1], (DEC_BATCH, DEC_SEQ, D_MODEL), 1.0),
        'c_prompt': nrm(ks[2], (BATCH, D_MODEL), 1.0),
        'c_sample': nrm(ks[3], (DEC_BATCH, D_MODEL), 1.0),
        'ada_w': nrm(ks[4], (DEPTH, D_MODEL, N_MOD * D_MODEL), 0.5 * D_MODEL ** -0.5),
        'ada_b': nrm(ks[5], (DEPTH, N_MOD * D_MODEL), 0.02),
        'norm1_g': 1.0 + nrm(ks[6], (DEPTH, D_MODEL), 0.05),
        'w_in': nrm(ks[7], (DEPTH, D_MODEL, IN_COLS), D_MODEL ** -0.5),
        'w0': base_decay + nrm(ks[8], (DEPTH, N_DIR, RWKV_WIDTH), 0.1),
        'w2': nrm(ks[9], (DEPTH, N_DIR, DECAY_RANK, RWKV_WIDTH), 0.5 * DECAY_RANK ** -0.5),
        'a0': nrm(ks[10], (DEPTH, N_DIR, RWKV_WIDTH), 0.1),
        'a2': nrm(ks[11], (DEPTH, N_DIR, ICLR_RANK, RWKV_WIDTH), 0.5 * ICLR_RANK ** -0.5),
        'g2': nrm(ks[12], (DEPTH, GATE_RANK, RWKV_WIDTH), GATE_RANK ** -0.5),
        'k_k': 0.85 + nrm(ks[13], (DEPTH, RWKV_WIDTH), 0.05),
        'k_a': 1.0 + nrm(ks[14], (DEPTH, RWKV_WIDTH), 0.05),
        'r_k': nrm(ks[15], (DEPTH, N_HEADS, HEAD_DIM), 0.1),
        'lnx_w': 1.0 + nrm(ks[16], (DEPTH, RWKV_WIDTH), 0.05),
        'lnx_b': nrm(ks[17], (DEPTH, RWKV_WIDTH), 0.02),
        'pool_w': nrm(ks[18], (DEPTH, N_POOL_GROUPS, POOL_GROUP_WIDTH, POOL_GROUP_WIDTH), POOL_GROUP_WIDTH ** -0.5),
        'pool_scale': 1.0 + nrm(ks[19], (DEPTH, POOL_WIDTH), 0.05),
        'w_out': nrm(ks[20], (DEPTH, MIX_WIDTH, D_MODEL), MIX_WIDTH ** -0.5),
        'norm2_g': 1.0 + nrm(ks[21], (DEPTH, D_MODEL), 0.05),
        'mlp_w1': nrm(ks[22], (DEPTH, D_MODEL, D_FF), D_MODEL ** -0.5),
        'mlp_w2': nrm(ks[23], (DEPTH, D_FF, D_MODEL), D_FF ** -0.5),
        'final_g': 1.0 + nrm(ks[24], (D_MODEL,), 0.05),
    }


def reference(x_prompt, x_sample, c_prompt, c_sample, ada_w, ada_b, norm1_g, w_in, w0, w2,
              a0, a2, g2, k_k, k_a, r_k, lnx_w, lnx_b, pool_w, pool_scale, w_out, norm2_g,
              mlp_w1, mlp_w2, final_g):
    y_prompt = trunk(x_prompt, c_prompt, ada_w, ada_b, norm1_g, w_in, w0, w2, a0, a2, g2,
                     k_k, k_a, r_k, lnx_w, lnx_b, pool_w, pool_scale, w_out, norm2_g,
                     mlp_w1, mlp_w2, final_g)
    y_sample = trunk(x_sample, c_sample, ada_w, ada_b, norm1_g, w_in, w0, w2, a0, a2, g2,
                     k_k, k_a, r_k, lnx_w, lnx_b, pool_w, pool_scale, w_out, norm2_g,
                     mlp_w1, mlp_w2, final_g)
    return (y_prompt, y_sample)
```

```cpp
#include <hip/hip_runtime.h>
#include <cstdio>
#include <cstdint>
#ifndef REP_P2
#define REP_P2 1
#endif
#ifndef REP_P4B
#define REP_P4B 1
#endif
#ifndef REP_S2
#define REP_S2 1
#endif
#ifndef REP_P9
#define REP_P9 1
#endif
#ifndef REP_P4BC
#define REP_P4BC 1
#endif
#ifndef REP_P0
#define REP_P0 1
#endif
#ifndef REP_MISC
#define REP_MISC 1
#endif
#ifndef REP_P6
#define REP_P6 1
#endif

namespace pg8 {
#define PG8_LAS __attribute__((address_space(3)))
typedef unsigned short bf16_t;
typedef short bf16x8 __attribute__((ext_vector_type(8)));
typedef float f32x4 __attribute__((ext_vector_type(4)));
typedef unsigned u32x4 __attribute__((ext_vector_type(4)));
constexpr int BM = 256, BK = 64, HALF = 128, HTB = HALF * BK * 2, STAGE_BYTES = 8 * HTB, NXCD = 8, WGM = 8;

__host__ __device__ __forceinline__ int lds_byte(int r, int c) { const int st = (r >> 4) * 2 + (c >> 5), rr = r & 15, cc = c & 31, ob = rr * 64 + cc * 2; return st * 1024 + (ob ^ (((ob >> 9) & 1) << 5)); }
__host__ __device__ __forceinline__ void stage_rc(int b, int& R, int& C) { const int st = b / 1024, sb = b % 1024, swz = sb ^ (((sb >> 9) & 1) << 5); R = (st >> 1) * 16 + swz / 64; C = (st & 1) * 32 + (swz % 64) / 2; }
__host__ __device__ __forceinline__ int perm32(int rho) { const int n = rho >> 4, i = rho & 15; return 8 * (i >> 2) + 4 * n + (i & 3); }

struct Unit { int pm, pn; };
struct Gemm { const bf16_t* A; const bf16_t* Bt; int M, N, K, lda, ldb, apn; };

struct StaticOrder {
    int nM, nN, nwg, G, c;
    __host__ __device__ void init(int M, int N, int G_, int c_) { nM = M / BM; nN = N / BM; nwg = nM * nN; G = G_; c = c_; }
    __host__ __device__ bool next(int i, Unit& u) const {
        const long L = (long)i * G + c; if (L >= nwg || c < 0) return false;
        int wgid = (int)L; { const int q = nwg / NXCD, r = nwg % NXCD, xcd = wgid % NXCD, off = wgid / NXCD; wgid = (xcd < r ? xcd * (q + 1) : r * (q + 1) + (xcd - r) * q) + off; }
        const int nig = WGM * nN, gid = wgid / nig, fm = gid * WGM, gsz = (nM - fm) < WGM ? (nM - fm) : WGM;
        u.pm = fm + ((wgid % nig) % gsz); u.pn = (wgid % nig) / gsz; return true;
    }
    __device__ __forceinline__ void a_ready(const Unit&) const {}
    __device__ __forceinline__ void done(const Unit&) const {}
};

typedef float f32x2c __attribute__((ext_vector_type(2))); typedef __bf16 bf16x2c __attribute__((ext_vector_type(2)));
__device__ __forceinline__ unsigned cvt_pk_bf16(float lo, float hi) { const f32x2c v = {lo, hi}; const bf16x2c b = __builtin_convertvector(v, bf16x2c); return __builtin_bit_cast(unsigned, b); }

struct EpiF32 {
    static constexpr bool PERM = false;
    float* C; int ldc;
    __device__ __forceinline__ void operator()(const f32x4 (&acc)[2][2][4][2], const Unit& u, int wr, int wc, int fr, int fq) const {
        const int row0 = u.pm * BM + wr * 64 + fr, col0 = u.pn * BM + wc * 32 + 4 * fq;
#pragma unroll
        for (int ai = 0; ai < 2; ++ai)
#pragma unroll
            for (int m = 0; m < 4; ++m) { float* rowp = C + (size_t)(row0 + ai * HALF + m * 16) * ldc + col0;
#pragma unroll
                for (int bj = 0; bj < 2; ++bj)
#pragma unroll
                    for (int n = 0; n < 2; ++n) *(f32x4*)(rowp + bj * HALF + n * 16) = acc[ai][bj][m][n]; }
    }
};
struct EpiResGate {
    static constexpr bool PERM = true;
    const float* srcf0; const float* srcf1; bf16_t* xr; const float* gate;
    __device__ __forceinline__ void operator()(const f32x4 (&acc)[2][2][4][2], const Unit& u, int wr, int wc, int, int) const {
        int ln = threadIdx.x; asm volatile("" : "+v"(ln)); const int fr = ln & 15, fq = (ln & 63) >> 4;
        const int rowt = u.pm * BM; const int sq = rowt < 16384 ? (rowt >> 13) : 2 + ((rowt - 16384) >> 12);
        const float* srcf = rowt < 16384 ? srcf0 : srcf1; const float* gp = gate + sq * 12288;
        const int row0 = rowt + wr * 64 + fr, col0 = u.pn * BM + wc * 32 + 8 * fq;
#pragma unroll
        for (int bj = 0; bj < 2; ++bj) { const f32x4 g0 = *(const f32x4*)(gp + col0 + bj * HALF), g1 = *(const f32x4*)(gp + col0 + bj * HALF + 4);
#pragma unroll
            for (int ai = 0; ai < 2; ++ai)
#pragma unroll
                for (int m = 0; m < 4; ++m) { const size_t off = (size_t)(row0 + ai * HALF + m * 16) * 2048 + col0 + bj * HALF;
                    f32x4 x0, x1;
                    if (srcf0) { x0 = *(const f32x4*)(srcf + off); x1 = *(const f32x4*)(srcf + off + 4); }
                    else { const u32x4 w = *(const u32x4*)(xr + off);
                        x0[0] = __builtin_bit_cast(float, w.x << 16); x0[1] = __builtin_bit_cast(float, w.x & 0xffff0000u); x0[2] = __builtin_bit_cast(float, w.y << 16); x0[3] = __builtin_bit_cast(float, w.y & 0xffff0000u);
                        x1[0] = __builtin_bit_cast(float, w.z << 16); x1[1] = __builtin_bit_cast(float, w.z & 0xffff0000u); x1[2] = __builtin_bit_cast(float, w.w << 16); x1[3] = __builtin_bit_cast(float, w.w & 0xffff0000u); }
                    const f32x4 o0 = x0 + g0 * acc[ai][bj][m][0], o1 = x1 + g1 * acc[ai][bj][m][1];
                    u32x4 ow; ow.x = cvt_pk_bf16(o0[0], o0[1]); ow.y = cvt_pk_bf16(o0[2], o0[3]); ow.z = cvt_pk_bf16(o1[0], o1[1]); ow.w = cvt_pk_bf16(o1[2], o1[3]);
                    *(u32x4*)(xr + off) = ow; } }
    }
};
template <int ACT> struct EpiBf16 {
    static constexpr bool PERM = true;
    bf16_t* O; int ldc; const float* scale;
    __device__ __forceinline__ void operator()(const f32x4 (&acc)[2][2][4][2], const Unit& u, int wr, int wc, int, int) const {
        int ln = threadIdx.x; asm volatile("" : "+v"(ln)); const int fr = ln & 15, fq = (ln & 63) >> 4;
        const int row0 = u.pm * BM + wr * 64 + fr; const int col0 = u.pn * BM + wc * 32 + 8 * fq;
#pragma unroll
        for (int ai = 0; ai < 2; ++ai)
#pragma unroll
            for (int m = 0; m < 4; ++m) { bf16_t* rowp = O + (size_t)(row0 + ai * HALF + m * 16) * ldc + col0;
#pragma unroll
                for (int bj = 0; bj < 2; ++bj) { f32x4 v0 = acc[ai][bj][m][0], v1 = acc[ai][bj][m][1];
                    if (ACT == 1) {
#pragma unroll
                        for (int q = 0; q < 4; ++q) { v0[q] = __builtin_amdgcn_fmed3f(v0[q], 0.f, 3.0e38f); v1[q] = __builtin_amdgcn_fmed3f(v1[q], 0.f, 3.0e38f); }
                        v0 = v0 * v0; v1 = v1 * v1; }
                    if (scale) { v0 = v0 * *(const f32x4*)(scale + col0 + bj * HALF); v1 = v1 * *(const f32x4*)(scale + col0 + bj * HALF + 4); }
                    u32x4 w; w.x = cvt_pk_bf16(v0[0], v0[1]); w.y = cvt_pk_bf16(v0[2], v0[3]); w.z = cvt_pk_bf16(v1[0], v1[1]); w.w = cvt_pk_bf16(v1[2], v1[3]);
                    *(u32x4*)(rowp + bj * HALF) = w; } }
    }
};

template <class Epi, class Sched, bool ALIGN_EPI = false>
__device__ __forceinline__ void gemm_phase(PG8_LAS unsigned char* lds, const Gemm g, const Sched& S, const Epi& E) {
    int tid = threadIdx.x; asm volatile("" : "+v"(tid));
    const int wid = __builtin_amdgcn_readfirstlane(tid >> 6), lane = tid & 63, wr = wid >> 2, wc = wid & 3, fr = lane & 15, fq = lane >> 4;
    const int K = g.K, nt = K / BK;
    unsigned voffA[2], voffB[2];
#pragma unroll
    for (int i = 0; i < 2; ++i) { int R, C; stage_rc(tid * 16 + i * 8192, R, C); const int Rb = Epi::PERM ? ((R & ~31) + perm32(R & 31)) : R;
        voffA[i] = (unsigned)(R * g.lda + C) * 2u; voffB[i] = (unsigned)(Rb * g.ldb + C) * 2u; }
    const size_t kstep = (size_t)(BK * 2);
    const size_t hsA = (size_t)HALF * g.lda * 2, hsB = (size_t)HALF * g.ldb * 2;
    const size_t tsA = 2 * hsA, tsB = 2 * hsB;
    const unsigned ldsw = (unsigned)wid * 1024u;
    const int aoff = lds_byte(wr * 64 + fr, fq * 8), boff = lds_byte(wc * 32 + fr, fq * 8);
#define PG8_SA(b, h) (((b) * 2 + (h)) * HTB)
#define PG8_SB(b, h) ((4 + (b) * 2 + (h)) * HTB)
#define PG8_STAGE(bufoff, gbase, voff) do { _Pragma("unroll") for (int _i = 0; _i < 2; ++_i) \
        __builtin_amdgcn_global_load_lds((const unsigned*)((const char*)(gbase) + (voff)[_i]), (PG8_LAS unsigned*)(lds + (bufoff) + ldsw + _i * 8192), 16, 0, 0); } while (0)
#define PG8_LDA(dst, b, h) do { _Pragma("unroll") for (int m = 0; m < 4; ++m) _Pragma("unroll") for (int k = 0; k < 2; ++k) dst[m][k] = *(const PG8_LAS bf16x8*)(lds + PG8_SA(b, h) + aoff + m * 2048 + k * 1024); } while (0)
#define PG8_LDB(dst, b, h) do { _Pragma("unroll") for (int n = 0; n < 2; ++n) _Pragma("unroll") for (int k = 0; k < 2; ++k) dst[n][k] = *(const PG8_LAS bf16x8*)(lds + PG8_SB(b, h) + boff + n * 2048 + k * 1024); } while (0)
#define PG8_MMA(ai, bj, At, Bt) do { __builtin_amdgcn_s_setprio(1); _Pragma("unroll") for (int m = 0; m < 4; ++m) _Pragma("unroll") for (int n = 0; n < 2; ++n) _Pragma("unroll") for (int k = 0; k < 2; ++k) \
        acc[ai][bj][m][n] = __builtin_amdgcn_mfma_f32_16x16x32_bf16(Bt[n][k], At[m][k], acc[ai][bj][m][n], 0, 0, 0); __builtin_amdgcn_s_setprio(0); } while (0)
#define PG8_WAIT_V(n) asm volatile("s_waitcnt vmcnt(" #n ")" ::: "memory")
#define PG8_WAIT_L(n) asm volatile("s_waitcnt lgkmcnt(" #n ")" ::: "memory")
#define PG8_BAR __builtin_amdgcn_s_barrier()
#define PG8_SCHED __builtin_amdgcn_sched_barrier(0)
    Unit cur, nxt; int ui = 0;
    if (!S.next(0, cur)) return;
    f32x4 acc[2][2][4][2];
#pragma unroll
    for (int a = 0; a < 2; ++a)
#pragma unroll
        for (int b = 0; b < 2; ++b)
#pragma unroll
            for (int m = 0; m < 4; ++m)
#pragma unroll
                for (int n = 0; n < 2; ++n) acc[a][b][m][n] = (f32x4){0.f, 0.f, 0.f, 0.f};
    bf16x8 At[4][2], B0[2][2], B1[2][2];
    const char* cA = (const char*)g.A + (size_t)cur.pm * tsA + (size_t)cur.pn * g.apn * 2; const char* cB = (const char*)g.Bt + (size_t)cur.pn * tsB;
    S.a_ready(cur);
    PG8_STAGE(PG8_SB(0, 0), cB, voffB); PG8_STAGE(PG8_SB(0, 1), cB + hsB, voffB); PG8_STAGE(PG8_SA(0, 0), cA, voffA); PG8_STAGE(PG8_SA(0, 1), cA + hsA, voffA);
    if (wr == 1) PG8_BAR;
    PG8_WAIT_V(2); PG8_BAR;
    PG8_STAGE(PG8_SB(1, 0), cB + kstep, voffB); PG8_STAGE(PG8_SA(1, 0), cA + kstep, voffA); PG8_STAGE(PG8_SB(1, 1), cB + hsB + kstep, voffB);
    PG8_WAIT_V(6); PG8_BAR;
    for (;;) {
        const bool has_next = S.next(ui + 1, nxt);
        const char* nA = has_next ? (const char*)g.A + (size_t)nxt.pm * tsA + (size_t)nxt.pn * g.apn * 2 : cA; const char* nB = has_next ? (const char*)g.Bt + (size_t)nxt.pn * tsB : cB;
        for (int t = 0; t < nt; t += 2) {
            const bool last = (t == nt - 2);
            const char* a1 = cA + (size_t)(t + 1) * kstep;
            const char* a2 = last ? nA : cA + (size_t)(t + 2) * kstep; const char* b2 = last ? nB : cB + (size_t)(t + 2) * kstep;
            const char* a3 = a2 + kstep; const char* b3 = b2 + kstep;
            if (last && has_next) S.a_ready(nxt);
            PG8_LDB(B0, 0, 0); PG8_LDB(B1, 0, 1); PG8_SCHED; PG8_LDA(At, 0, 0); PG8_STAGE(PG8_SA(1, 1), a1 + hsA, voffA);
            PG8_WAIT_V(8); PG8_WAIT_L(0); PG8_BAR; PG8_MMA(0, 0, At, B0); PG8_MMA(0, 1, At, B1); PG8_BAR; PG8_SCHED;
            PG8_LDA(At, 0, 1); PG8_STAGE(PG8_SB(0, 0), b2, voffB); PG8_STAGE(PG8_SB(0, 1), b2 + hsB, voffB); PG8_STAGE(PG8_SA(0, 0), a2, voffA);
            PG8_WAIT_V(8); PG8_WAIT_L(0); PG8_BAR; PG8_MMA(1, 0, At, B0); PG8_MMA(1, 1, At, B1); PG8_BAR; PG8_SCHED;
            PG8_LDB(B0, 1, 0); PG8_LDB(B1, 1, 1); PG8_SCHED; PG8_LDA(At, 1, 0); PG8_STAGE(PG8_SA(0, 1), a2 + hsA, voffA);
            PG8_WAIT_V(8); PG8_WAIT_L(0); PG8_BAR; PG8_MMA(0, 0, At, B0); PG8_MMA(0, 1, At, B1); PG8_BAR; PG8_SCHED;
            PG8_LDA(At, 1, 1); PG8_STAGE(PG8_SB(1, 0), b3, voffB); PG8_STAGE(PG8_SB(1, 1), b3 + hsB, voffB); PG8_STAGE(PG8_SA(1, 0), a3, voffA);
            PG8_WAIT_V(8); PG8_WAIT_L(0); PG8_BAR; PG8_MMA(1, 0, At, B0); PG8_MMA(1, 1, At, B1); PG8_BAR; PG8_SCHED;
        }
        if constexpr (ALIGN_EPI) { if (wr == 0) PG8_BAR; }
        E(acc, cur, wr, wc, fr, fq); S.done(cur);
        if (!has_next) break;
#pragma unroll
        for (int a = 0; a < 2; ++a)
#pragma unroll
            for (int b = 0; b < 2; ++b)
#pragma unroll
                for (int m = 0; m < 4; ++m)
#pragma unroll
                    for (int n = 0; n < 2; ++n) acc[a][b][m][n] = (f32x4){0.f, 0.f, 0.f, 0.f};
        cur = nxt; cA = nA; cB = nB; ++ui;
        if constexpr (ALIGN_EPI) { if (wr == 1) PG8_BAR; }
    }
    PG8_WAIT_V(0);
    if constexpr (!ALIGN_EPI) { if (wr == 0) PG8_BAR; }
    PG8_BAR;
#undef PG8_SA
#undef PG8_SB
#undef PG8_STAGE
#undef PG8_LDA
#undef PG8_LDB
#undef PG8_MMA
#undef PG8_WAIT_V
#undef PG8_WAIT_L
#undef PG8_BAR
#undef PG8_SCHED
}
}

constexpr int NWAVES = 8;
constexpr int DM = 2048, NTOK = 24576, DEPTH = 4, INC = 4512, INCP = 4608, DFF = 8192, RW = 1024, NH = 16, HD = 64;
constexpr int C_R = 0, C_K = 1024, C_V = 2048, C_XW = 3072, C_XA = 3200, C_XG = 3328, C_U = 3488;
constexpr float NORM_EPS = 1e-6f, GN_EPS = 64e-5f;
__device__ __forceinline__ int seq_of_row(int m) { return m < 16384 ? (m >> 13) : 2 + ((m - 16384) >> 12); }
__device__ __forceinline__ int seq_base(int s) { return s < 2 ? s * 8192 : 16384 + (s - 2) * 4096; }
__device__ __forceinline__ int seq_len(int s) { return s < 2 ? 8192 : 4096; }

constexpr size_t MiB = 1u << 20;
constexpr size_t WS_CTL = 0, CTL_ZERO_BYTES = 1 * MiB;
constexpr size_t WS_MOD = 1 * MiB;
constexpr size_t WS_BON = 2 * MiB;
constexpr size_t WS_POOLW = 6 * MiB;
constexpr size_t WS_WIN = 8 * MiB;
constexpr size_t WS_WOUT = 80 * MiB;
constexpr size_t WS_W1 = 112 * MiB;
constexpr size_t WS_W2 = 240 * MiB;
constexpr size_t WS_H = 368 * MiB;
constexpr size_t WS_MIX = 464 * MiB;
constexpr size_t WS_POOLED = 560 * MiB;
constexpr size_t WS_Y = 608 * MiB;
constexpr size_t WS_P = 800 * MiB;
constexpr size_t WS_F1 = 800 * MiB;
constexpr size_t WS_PM = 1196 * MiB;
constexpr size_t WS_QT = 1292 * MiB;
constexpr size_t WS_RH = 368 * MiB;
constexpr size_t WS_W2T = 1388 * MiB, WS_A2T = 1389 * MiB;
constexpr size_t WS_GATE = 1390 * MiB;
constexpr size_t WS_G2T = 1438 * MiB;
constexpr size_t WS_SGX = 1184 * MiB;
constexpr size_t WS_XR = 704 * MiB;
constexpr size_t WS_YLT = 1016 * MiB;
constexpr size_t WS_END = 1440 * MiB;
constexpr int CW_TMO = 0, CW_BAR = 4096;
constexpr size_t WS_SCR = 512 * 1024;

constexpr int RING_OFF = 0, RING_BYTES = 131072;
constexpr int LDSCTL_OFF = RING_BYTES, MISC_OFF = LDSCTL_OFF + 320;
constexpr int LDS_BYTES = 151552;

#define GAS __attribute__((address_space(1)))
#define LAS __attribute__((address_space(3)))
typedef unsigned short bf16;
typedef unsigned v4u __attribute__((ext_vector_type(4)));
typedef unsigned v2u __attribute__((ext_vector_type(2)));
typedef float f32x4 __attribute__((ext_vector_type(4)));
typedef GAS unsigned gu32;
#define RLX_AGENT __ATOMIC_RELAXED, __HIP_MEMORY_SCOPE_AGENT
#define LDS_WAIT() asm volatile("s_waitcnt lgkmcnt(0)" ::: "memory")
#define VM_WAIT() asm volatile("s_waitcnt vmcnt(0)" ::: "memory")
#define LBAR() do { asm volatile("s_waitcnt lgkmcnt(0)" ::: "memory"); __builtin_amdgcn_s_barrier(); asm volatile("" ::: "memory"); } while (0)
typedef float f32x2_t __attribute__((ext_vector_type(2)));
typedef __bf16 bf16x2_t __attribute__((ext_vector_type(2)));
__device__ __forceinline__ unsigned pk2(float lo, float hi) { const f32x2_t v = {lo, hi}; const bf16x2_t b = __builtin_convertvector(v, bf16x2_t); return __builtin_bit_cast(unsigned, b); }
__device__ __forceinline__ unsigned f2bf(float f) { return pk2(f, 0.f) & 0xffffu; }

#define XB_TMO      128
#define XB_XCNT(j)  (256  + 64 * (j))
#define XB_XSUB(j)  (1280 + 64 * (j))
#define XB_XGEN(j)  (2304 + 64 * (j))
#define XB_TOP      3328
#define XB_TOPGEN   3392
#define XCD_BAR_WORDS 3456
#define XB_SPIN_CAP (1u << 22)

__device__ __forceinline__ unsigned xb_ld(unsigned* p)              { return __hip_atomic_load(p, __ATOMIC_RELAXED, __HIP_MEMORY_SCOPE_AGENT); }
__device__ __forceinline__ unsigned xb_add(unsigned* p, unsigned v) { return __hip_atomic_fetch_add(p, v, __ATOMIC_RELAXED, __HIP_MEMORY_SCOPE_AGENT); }
__device__ __forceinline__ unsigned xb_xcc_id() { return (unsigned)__builtin_amdgcn_s_getreg((3 << 11) | 20) & 0xFu; }
#define XB_SPIN(cond, bar) do { unsigned _sp = 0; while (cond) { __builtin_amdgcn_s_sleep(1); \
    if ((++_sp & 255u) == 0u) { if (xb_ld(&(bar)[XB_TMO])) break; if (_sp > XB_SPIN_CAP) { atomicAdd(&(bar)[XB_TMO], 1u); break; } } } } while (0)

struct XcdBarrier { unsigned* bar; unsigned x; volatile LAS unsigned* st; };

__device__ __forceinline__ XcdBarrier xcd_barrier_post(unsigned* bar, volatile LAS unsigned* st) {
    XcdBarrier b; b.bar = bar; b.x = xb_xcc_id(); b.st = st;
    if (threadIdx.x == 0) (void)xb_add(&bar[XB_XCNT(b.x)], 1u);
    return b;
}
__device__ __forceinline__ void xcd_barrier_complete(unsigned* bar, unsigned x, unsigned& nloc, unsigned& nx) {
    const unsigned G = gridDim.x * gridDim.y * gridDim.z;
    unsigned sum, cnt, mine, sp = 0u;
    for (;;) {
        sum = 0u; cnt = 0u; mine = 0u;
#pragma unroll
        for (unsigned j = 0; j < 16; ++j) { const unsigned c = xb_ld(&bar[XB_XCNT(j)]); sum += c; cnt += (c > 0u) ? 1u : 0u; mine = (j == x) ? c : mine; }
        if (sum == G) break;
        __builtin_amdgcn_s_sleep(1);
        if ((++sp & 255u) == 0u) { if (xb_ld(&bar[XB_TMO])) break; if (sp > XB_SPIN_CAP) { atomicAdd(&bar[XB_TMO], 1u); break; } }
    }
    nloc = mine > 0u ? mine : 1u; nx = cnt > 0u ? cnt : 1u;
}
__device__ __forceinline__ void xcd_barrier(const XcdBarrier& b_) {
    asm volatile("s_waitcnt vmcnt(0)" ::: "memory");
    __syncthreads();
    if (threadIdx.x == 0) {
        XcdBarrier b; b.bar = b_.bar; b.st = b_.st; b.x = xb_xcc_id();
        unsigned* bar = b.bar;
        __builtin_amdgcn_s_waitcnt(0);
        unsigned nloc = b.st[0], nx = b.st[1];
        if (nloc == 0u) { xcd_barrier_complete(bar, b.x, nloc, nx); b.st[0] = nloc; b.st[1] = nx; }
        const unsigned old = xb_add(&bar[XB_XSUB(b.x)], 1u);
        const unsigned gen = old / nloc;
        if (old + 1u == (gen + 1u) * nloc) {
            __builtin_amdgcn_fence(__ATOMIC_RELEASE, "agent");
            asm volatile("s_waitcnt vmcnt(0)" ::: "memory");
            const unsigned og = xb_add(&bar[XB_TOP], 1u);
            const unsigned tg = og / nx;
            if (og + 1u == (tg + 1u) * nx) xb_add(&bar[XB_TOPGEN], 1u);
            else XB_SPIN(xb_ld(&bar[XB_TOPGEN]) == tg, bar);
            __builtin_amdgcn_fence(__ATOMIC_ACQUIRE, "agent");
            xb_add(&bar[XB_XGEN(b.x)], 1u);
            asm volatile("s_waitcnt vmcnt(0)" ::: "memory");
        } else {
            XB_SPIN(xb_ld(&bar[XB_XGEN(b.x)]) == gen, bar);
            __builtin_amdgcn_fence(__ATOMIC_ACQUIRE, "agent");
            asm volatile("s_waitcnt vmcnt(0)" ::: "memory");
        }
    }
    __syncthreads();
}

struct Args { const float* in[25]; float* out; unsigned char* ws; };
enum { I_XP = 0, I_XS, I_CP, I_CS, I_ADAW, I_ADAB, I_N1G, I_WIN, I_W0, I_W2, I_A0, I_A2, I_G2, I_KK, I_KA, I_RK, I_LNW, I_LNB, I_POOLW, I_POOLS, I_WOUT, I_N2G, I_MW1, I_MW2, I_FG };

template <int CTRL> __device__ __forceinline__ float dpp_f(float x) {
    return __builtin_bit_cast(float, __builtin_amdgcn_update_dpp(0, __builtin_bit_cast(int, x), CTRL, 0xF, 0xF, true));
}
__device__ __forceinline__ float red8(float x) {
    x += dpp_f<0xB1>(x); x += dpp_f<0x4E>(x); x += dpp_f<0x141>(x); return x;
}
__device__ __forceinline__ float row16_sum(float x) {
    x += dpp_f<0xB1>(x); x += dpp_f<0x4E>(x); x += dpp_f<0x141>(x); x += dpp_f<0x140>(x); return x;
}
__device__ __forceinline__ float wave_sum(float x) {
    x += dpp_f<0xB1>(x); x += dpp_f<0x4E>(x); x += dpp_f<0x141>(x); x += dpp_f<0x140>(x);
    x += __builtin_bit_cast(float, __builtin_amdgcn_update_dpp(0, __builtin_bit_cast(int, x), 0x142, 0xA, 0xF, false));
    x += __builtin_bit_cast(float, __builtin_amdgcn_update_dpp(0, __builtin_bit_cast(int, x), 0x143, 0xC, 0xF, false));
    return __builtin_bit_cast(float, __builtin_amdgcn_readlane(__builtin_bit_cast(int, x), 63));
}
__device__ __forceinline__ f32x4 bf4_f32(v2u w) { f32x4 r; r.x = __builtin_bit_cast(float, w.x << 16); r.y = __builtin_bit_cast(float, w.x & 0xffff0000u); r.z = __builtin_bit_cast(float, w.y << 16); r.w = __builtin_bit_cast(float, w.y & 0xffff0000u); return r; }
__device__ __forceinline__ float bf1_f32(bf16 b) { return __builtin_bit_cast(float, (unsigned)b << 16); }
__device__ __forceinline__ float sigmoidf_(float x) { return __builtin_amdgcn_rcpf(1.f + __expf(-x)); }
__device__ __forceinline__ float tanh_fast(float x) { return 1.f - 2.f * __builtin_amdgcn_rcpf(1.f + __expf(2.f * x)); }
__device__ __forceinline__ float softplus_fast(float z) { return fmaxf(z, 0.f) + __logf(1.f + __expf(-fabsf(z))); }


constexpr int LDB = 72, LDF = 68;
constexpr int SEG_OFF = 131072 + 512;
constexpr int DB_OFF = SEG_OFF + 2304, DBLD = 20;
constexpr int SLOTX_OFF = DB_OFF + 5120;
static_assert(SLOTX_OFF % 16 == 0 && SLOTX_OFF + 9216 <= 151552, "LDS map");
__device__ __forceinline__ void mm_acc(f32x4 (&acc)[2], const LAS bf16* X, const LAS bf16* Y, int it, int jt0, int fr, int fq) {
#pragma unroll
    for (int ks = 0; ks < 2; ++ks) { const pg8::bf16x8 bfrag = *(const LAS pg8::bf16x8*)(X + (16 * it + fr) * LDB + 32 * ks + 8 * fq);
#pragma unroll
        for (int jj = 0; jj < 2; ++jj) { const pg8::bf16x8 afrag = *(const LAS pg8::bf16x8*)(Y + (16 * (jt0 + jj) + fr) * LDB + 32 * ks + 8 * fq);
            acc[jj] = __builtin_amdgcn_mfma_f32_16x16x32_bf16(afrag, bfrag, acc[jj], 0, 0, 0); } }
}
__device__ __forceinline__ void mm_acc4(f32x4 (&acc)[2][2], const LAS bf16* X, const LAS bf16* Y, int i2, int j2, int fr, int fq) {
#pragma unroll
    for (int ks = 0; ks < 2; ++ks) { pg8::bf16x8 bf[2], af[2];
#pragma unroll
        for (int t = 0; t < 2; ++t) { bf[t] = *(const LAS pg8::bf16x8*)(X + (16 * (2 * i2 + t) + fr) * LDB + 32 * ks + 8 * fq); af[t] = *(const LAS pg8::bf16x8*)(Y + (16 * (2 * j2 + t) + fr) * LDB + 32 * ks + 8 * fq); }
#pragma unroll
        for (int ii = 0; ii < 2; ++ii)
#pragma unroll
            for (int jj = 0; jj < 2; ++jj) acc[ii][jj] = __builtin_amdgcn_mfma_f32_16x16x32_bf16(af[jj], bf[ii], acc[ii][jj], 0, 0, 0); }
}
__device__ __forceinline__ pg8::bf16x8 ld_perm(const LAS bf16* M, int row, int c, int fq) {
    const v2u lo = *(const LAS v2u*)(M + row * LDB + 32 * c + 4 * fq), hi = *(const LAS v2u*)(M + row * LDB + 32 * c + 16 + 4 * fq);
    const v4u w = {lo.x, lo.y, hi.x, hi.y}; return __builtin_bit_cast(pg8::bf16x8, w);
}
__device__ __forceinline__ pg8::bf16x8 pack_op(f32x4 a, f32x4 b) { const v4u w = {pk2(a.x, a.y), pk2(a.z, a.w), pk2(b.x, b.y), pk2(b.z, b.w)}; return __builtin_bit_cast(pg8::bf16x8, w); }
__device__ __forceinline__ void st_bf4(LAS bf16* p, f32x4 v) { v2u w; w.x = pk2(v.x, v.y); w.y = pk2(v.z, v.w); *(LAS v2u*)p = w; }
__device__ __forceinline__ void gst_bf4(bf16* p, f32x4 v) { v2u w; w.x = pk2(v.x, v.y); w.y = pk2(v.z, v.w); *(GAS v2u*)p = w; }
__device__ __forceinline__ void p0_transpose_item(const float* W, int K, int N, bf16* WT, int row_off, LAS float* scr, int item, int lane) {
    const int nblk = N / 32, kb = item / nblk, nb = item % nblk, k0 = 64 * kb, n0 = 32 * nb;
    float tv_[32];
#pragma unroll
    for (int i = 0; i < 32; ++i) { const int kk = 2 * i + (lane >> 5); tv_[i] = W[(size_t)(k0 + kk) * N + n0 + (lane & 31)]; }
#pragma unroll
    for (int i = 0; i < 32; ++i) { const int kk = 2 * i + (lane >> 5); scr[kk * 33 + (lane & 31)] = tv_[i]; }
    LDS_WAIT(); asm volatile("" ::: "memory");
    const int c = lane & 7;
#pragma unroll
    for (int j = 0; j < 4; ++j) { const int n = (lane >> 3) + 8 * j; const LAS float* s = scr + (8 * c) * 33 + n;
        v4u o; o.x = pk2(s[0 * 33], s[1 * 33]); o.y = pk2(s[2 * 33], s[3 * 33]); o.z = pk2(s[4 * 33], s[5 * 33]); o.w = pk2(s[6 * 33], s[7 * 33]);
        *(GAS v4u*)(WT + (size_t)(row_off + n0 + n) * K + k0 + 8 * c) = o; }
    LDS_WAIT(); asm volatile("" ::: "memory");
}

__global__ void __launch_bounds__(NWAVES * 64, 2) hymba_fwd(Args args) {
    extern __shared__ __attribute__((aligned(16))) unsigned char lds_raw[];
    LAS unsigned char* lds = (LAS unsigned char*)lds_raw;
    volatile LAS unsigned* MISC = (volatile LAS unsigned*)(lds + MISC_OFF);
    const int G = gridDim.x; int bx = blockIdx.x;
    typedef const float* fptr_t;
    const __attribute__((address_space(4))) char* ka = (const __attribute__((address_space(4))) char*)__builtin_amdgcn_kernarg_segment_ptr();
#define RELAUNDER_KA asm volatile("" : "+s"(ka))
#define INP(i) (*(const __attribute__((address_space(4))) fptr_t*)(ka + 8 * (i)))
#define FRESH_IDS int tid = threadIdx.x; asm volatile("" : "+v"(tid)); const int lane = tid & 63, wave = __builtin_amdgcn_readfirstlane(tid >> 6); const int gw = bx * NWAVES + wave, NGW = G * NWAVES; (void)lane; (void)gw; (void)NGW;
    unsigned char* ws = args.ws;
    gu32* ctl = (gu32*)(ws + WS_CTL);
    float* out = args.out;
    float* MOD = (float*)(ws + WS_MOD); float* BON = (float*)(ws + WS_BON);
    bf16* POOLW = (bf16*)(ws + WS_POOLW); bf16* WINT = (bf16*)(ws + WS_WIN); bf16* WOUTT = (bf16*)(ws + WS_WOUT); bf16* W1T = (bf16*)(ws + WS_W1); bf16* W2T = (bf16*)(ws + WS_W2);
    bf16* HB = (bf16*)(ws + WS_H); bf16* MIX = (bf16*)(ws + WS_MIX); bf16* POOLED = (bf16*)(ws + WS_POOLED);
    bf16* PMB = (bf16*)(ws + WS_PM); bf16* QTB = (bf16*)(ws + WS_QT); bf16* RHB = (bf16*)(ws + WS_RH); bf16* W2TB = (bf16*)(ws + WS_W2T); bf16* A2TB = (bf16*)(ws + WS_A2T); bf16* GATE = (bf16*)(ws + WS_GATE); bf16* G2TB = (bf16*)(ws + WS_G2T); bf16* SGX = (bf16*)(ws + WS_SGX); bf16* XR = (bf16*)(ws + WS_XR); bf16* YLT = (bf16*)(ws + WS_YLT);
    bf16* YB = (bf16*)(ws + WS_Y);     bf16* PB = (bf16*)(ws + WS_P);   bf16* F1 = (bf16*)(ws + WS_F1);

    for (int u = threadIdx.x; u < (LDS_BYTES - LDSCTL_OFF) / 4; u += NWAVES * 64) ((LAS unsigned*)(lds + LDSCTL_OFF))[u] = 0u;
    __syncthreads();
    XcdBarrier bar = xcd_barrier_post((unsigned*)(ctl + CW_BAR), MISC + 8);
#define GRID_BAR() xcd_barrier(bar)

    for (int rep0_ = 0; rep0_ < REP_P0; ++rep0_) { if (rep0_) { GRID_BAR(); }
        FRESH_IDS
        LAS float* scr = (LAS float*)(lds + RING_OFF + wave * 16384);
        constexpr int I_IN = (DM / 64) * (INC / 32), I_OUT = (DM / 64) * (DM / 32), I_1 = (DM / 64) * (DFF / 32), I_2 = (DFF / 64) * (DM / 32), I_PL = 4 * (256 / 64) * (256 / 32);
        constexpr int PER_L = I_IN + I_OUT + I_1 + I_2 + I_PL;
        for (int it = gw; it < DEPTH * PER_L; it += NGW) {
            const int l = it / PER_L; int r = it % PER_L;
            if (r < I_IN) { p0_transpose_item(INP(I_WIN) + (size_t)l * DM * INC, DM, INC, WINT + (size_t)l * INCP * DM, 0, scr, r, lane); continue; } r -= I_IN;
            if (r < I_OUT) { p0_transpose_item(INP(I_WOUT) + (size_t)l * DM * DM, DM, DM, WOUTT + (size_t)l * DM * DM, 0, scr, r, lane); continue; } r -= I_OUT;
            if (r < I_1) { p0_transpose_item(INP(I_MW1) + (size_t)l * DM * DFF, DM, DFF, W1T + (size_t)l * DFF * DM, 0, scr, r, lane); continue; } r -= I_1;
            if (r < I_2) { p0_transpose_item(INP(I_MW2) + (size_t)l * DFF * DM, DFF, DM, W2T + (size_t)l * DM * DFF, 0, scr, r, lane); continue; } r -= I_2;
            { const int gi = r / 32, ri = r % 32; p0_transpose_item(INP(I_POOLW) + (size_t)(l * 4 + gi) * 65536, 256, 256, POOLW + (size_t)l * 1024 * 256, gi * 256, scr, ri, lane); }
        }
        for (int i = bx * 512 + tid; i < DEPTH * 24576; i += G * 512) { const int l = i / 24576, r = i % 24576; *((GAS v4u*)(WINT + (size_t)l * INCP * DM + (size_t)INC * DM) + r) = (v4u){0u, 0u, 0u, 0u}; }
        for (int i = bx * 512 + tid; i < 4 * 2 * 16 * 64 * 64; i += G * 512) { const int r = i & 63, nn = (i >> 6) & 63, hh = (i >> 12) & 15, ld = i >> 16;
            W2TB[i] = (bf16)f2bf(INP(I_W2)[((size_t)ld * 64 + r) * 1024 + hh * 64 + nn]); A2TB[i] = (bf16)f2bf(INP(I_A2)[((size_t)ld * 64 + r) * 1024 + hh * 64 + nn]); }
        for (int i = bx * 512 + tid; i < 4 * 1024 * 256; i += G * 512) { const int r = i & 255, cidx = (i >> 8) & 1023, ll = i >> 18;
            G2TB[i] = r < 160 ? (bf16)f2bf(INP(I_G2)[((size_t)ll * 160 + r) * 1024 + cidx]) : (bf16)0; }
        __syncthreads();
        LAS float* sc = (LAS float*)(lds + RING_OFF);
        LAS float* part = (LAS float*)(lds + RING_OFF + 32768);
        if (bx < 192 || G < 192) {
            for (int i = tid; i < 4 * 2048; i += 512) { const int b = i >> 11, k = i & 2047; const float c = (b < 2 ? INP(I_CP) : INP(I_CS))[(b & 1) * 2048 + k]; sc[k * 4 + b] = c / (1.f + __expf(-c)); }
            __syncthreads();
            for (int u = bx; u < 192; u += G) {
                const int l = u / 48, cb = u % 48; const float* Wb = INP(I_ADAW) + (size_t)l * DM * 12288 + cb * 256 + lane * 4;
                f32x4 a0 = {0.f, 0.f, 0.f, 0.f}, a1 = a0, a2 = a0, a3 = a0;
#pragma unroll 8
                for (int kk = 0; kk < 256; ++kk) { const int k = wave * 256 + kk; const f32x4 w = *(const f32x4*)(Wb + (size_t)k * 12288); const f32x4 s = *(const LAS f32x4*)(sc + k * 4);
                    a0 += s.x * w; a1 += s.y * w; a2 += s.z * w; a3 += s.w * w; }
                *(LAS f32x4*)(part + (wave * 4 + 0) * 256 + lane * 4) = a0; *(LAS f32x4*)(part + (wave * 4 + 1) * 256 + lane * 4) = a1;
                *(LAS f32x4*)(part + (wave * 4 + 2) * 256 + lane * 4) = a2; *(LAS f32x4*)(part + (wave * 4 + 3) * 256 + lane * 4) = a3;
                __syncthreads();
                for (int o = tid; o < 1024; o += 512) { const int b = o >> 8, c = o & 255; float s = 0.f;
#pragma unroll
                    for (int w = 0; w < 8; ++w) s += part[(w * 4 + b) * 256 + c];
                    MOD[((size_t)l * 4 + b) * 12288 + cb * 256 + c] = s + INP(I_ADAB)[l * 12288 + cb * 256 + c]; }
                __syncthreads();
            }
        }
    }
    GRID_BAR();

    for (int l_ = 0; l_ < DEPTH; ++l_) {
        int l = l_;
#define RELAUNDER_L do { asm volatile("" : "+s"(l), "+s"(bx)); RELAUNDER_KA; } while (0)
#define modl (MOD + (size_t)l * 4 * 12288)
#define xs0 (l == 0 ? INP(I_XP) : out)
#define xs1 (l == 0 ? INP(I_XS) - (size_t)16384 * DM : out)
        RELAUNDER_L;
#define NORM_PHASE(SRC0, SRC1, GVEC, SHC, SCC) do { FRESH_IDS \
        for (int m = gw; m < NTOK; m += NGW) { const int sq = seq_of_row(m); const float* xr = (m < 16384 ? (SRC0) : (SRC1)) + (size_t)m * DM; \
            const float* shp = modl + sq * 12288 + (SHC) * 2048; const float* scp = modl + sq * 12288 + (SCC) * 2048; \
            f32x4 v[8]; float ss = 0.f; \
            _Pragma("unroll") for (int j = 0; j < 8; ++j) { v[j] = *(const f32x4*)(xr + 4 * lane + 256 * j); ss += (v[j].x * v[j].x + v[j].y * v[j].y) + (v[j].z * v[j].z + v[j].w * v[j].w); } \
            const float rs = 1.0f / sqrtf(wave_sum(ss) * (1.f / DM) + NORM_EPS); \
            _Pragma("unroll") for (int j = 0; j < 8; ++j) { const int c = 4 * lane + 256 * j; const f32x4 gg = *(const f32x4*)((GVEC) + c), sh = *(const f32x4*)(shp + c), sc = *(const f32x4*)(scp + c); \
                const f32x4 o = (v[j] * rs * gg) * (1.f + sc) + sh; v2u w; w.x = pk2(o.x, o.y); w.y = pk2(o.z, o.w); *(GAS v2u*)(HB + (size_t)m * DM + c) = w; } } } while (0)
#define NORM_PHASE_BF(GVEC, SHC, SCC) do { FRESH_IDS        \
        for (int m0_ = gw; m0_ < NTOK; m0_ += 2 * NGW) { const bool two_ = m0_ + NGW < NTOK; const int m1_ = two_ ? m0_ + NGW : m0_; \
            v4u wa_[4], wb_[4]; \
            _Pragma("unroll") for (int j = 0; j < 4; ++j) { wa_[j] = *(const GAS v4u*)(XR + (size_t)m0_ * DM + 8 * lane + 512 * j); wb_[j] = *(const GAS v4u*)(XR + (size_t)m1_ * DM + 8 * lane + 512 * j); } \
            _Pragma("unroll") for (int rr_ = 0; rr_ < 2; ++rr_) { if (rr_ == 1 && !two_) break; const int m = rr_ ? m1_ : m0_; const int sq = seq_of_row(m); \
                const float* shp = modl + sq * 12288 + (SHC) * 2048; const float* scp = modl + sq * 12288 + (SCC) * 2048; \
                f32x4 v[8]; float ss = 0.f; \
                _Pragma("unroll") for (int j = 0; j < 4; ++j) { const v4u w = rr_ ? wb_[j] : wa_[j]; v[2 * j] = bf4_f32((v2u){w.x, w.y}); v[2 * j + 1] = bf4_f32((v2u){w.z, w.w}); } \
                _Pragma("unroll") for (int j = 0; j < 8; ++j) ss += (v[j].x * v[j].x + v[j].y * v[j].y) + (v[j].z * v[j].z + v[j].w * v[j].w); \
                const float rs = 1.0f / sqrtf(wave_sum(ss) * (1.f / DM) + NORM_EPS); \
                _Pragma("unroll") for (int j = 0; j < 4; ++j) { const int c = 8 * lane + 512 * j; v4u w; \
                    { const f32x4 gg = *(const f32x4*)((GVEC) + c), sh = *(const f32x4*)(shp + c), sc = *(const f32x4*)(scp + c); const f32x4 o = (v[2 * j] * rs * gg) * (1.f + sc) + sh; w.x = pk2(o.x, o.y); w.y = pk2(o.z, o.w); } \
                    { const f32x4 gg = *(const f32x4*)((GVEC) + c + 4), sh = *(const f32x4*)(shp + c + 4), sc = *(const f32x4*)(scp + c + 4); const f32x4 o = (v[2 * j + 1] * rs * gg) * (1.f + sc) + sh; w.z = pk2(o.x, o.y); w.w = pk2(o.z, o.w); } \
                    *(GAS v4u*)(HB + (size_t)m * DM + c) = w; } } } } while (0)
        if (l == 0) { NORM_PHASE(INP(I_XP), INP(I_XS) - (size_t)16384 * DM, INP(I_N1G) + l * DM, 0, 1); } else { NORM_PHASE_BF(INP(I_N1G) + l * DM, 0, 1); }
        GRID_BAR(); RELAUNDER_L;

        for (int rep_ = 0; rep_ < REP_P2; ++rep_) { if (rep_) { GRID_BAR(); RELAUNDER_L; } pg8::Gemm g{HB, WINT + (size_t)l * INCP * DM, NTOK, INCP, DM, DM, DM, 0}; pg8::StaticOrder S; S.init(NTOK, INCP, G, bx);
          pg8::EpiBf16<0> E{PB, INCP, nullptr};
          pg8::gemm_phase<pg8::EpiBf16<0>, pg8::StaticOrder, true>(lds + RING_OFF, g, S, E); }
        GRID_BAR(); RELAUNDER_L;

        for (int repn_ = 0; repn_ < REP_MISC; ++repn_) { if (repn_) { GRID_BAR(); RELAUNDER_L; } FRESH_IDS
        for (int i = bx * 512 + tid; i < (NTOK / 32) * 128; i += G * 512) {
            const int run = i >> 7, c8 = (i & 127) * 8, gi = c8 >> 8, hw = 1 << gi, m0 = run * 32;
            const int sq = seq_of_row(m0), sb = seq_base(sq), T = seq_len(sq), t0 = m0 - sb;
            const bf16* ub = PB + (size_t)sb * INCP + C_U + c8;
            f32x4 s0 = {0.f, 0.f, 0.f, 0.f}, s1 = s0;
            { const int lo = t0 - hw < 0 ? 0 : t0 - hw, hi = t0 + hw > T ? T : t0 + hw;
              for (int j = lo; j < hi; ++j) { const v4u x = *(const GAS v4u*)(ub + (size_t)j * INCP); s0 += bf4_f32((v2u){x.x, x.y}); s1 += bf4_f32((v2u){x.z, x.w}); } }
#pragma unroll 4
            for (int tt = 0; tt < 32; ++tt) { const int t = t0 + tt; const int lo = t - hw < 0 ? 0 : t - hw, hi = t + hw > T ? T : t + hw;
                const v4u ux = *(const GAS v4u*)(ub + (size_t)t * INCP);
                const int ta = t + hw < T ? t + hw : T - 1, tb = t - hw >= 0 ? t - hw : 0; const float ma = t + hw < T ? 1.f : 0.f, mb = t - hw >= 0 ? 1.f : 0.f;
                const v4u xa = *(const GAS v4u*)(ub + (size_t)ta * INCP), xb = *(const GAS v4u*)(ub + (size_t)tb * INCP);
                const float inv = 1.f / (float)(hi - lo);
                const f32x4 o0 = s0 * inv - bf4_f32((v2u){ux.x, ux.y}), o1 = s1 * inv - bf4_f32((v2u){ux.z, ux.w}); v4u w; w.x = pk2(o0.x, o0.y); w.y = pk2(o0.z, o0.w); w.z = pk2(o1.x, o1.y); w.w = pk2(o1.z, o1.w);
                *(GAS v4u*)(POOLED + (size_t)(sb + t) * 1024 + c8) = w;
                s0 += ma * bf4_f32((v2u){xa.x, xa.y}) - mb * bf4_f32((v2u){xb.x, xb.y}); s1 += ma * bf4_f32((v2u){xa.z, xa.w}) - mb * bf4_f32((v2u){xb.z, xb.w}); }
        }
        for (int i = bx * 512 + tid; i < NTOK * 64; i += G * 512) { const int m = i >> 6, c = (i & 63) * 4; v2u w = {0u, 0u};
            if (c < 160) { const f32x4 xg = bf4_f32(*(const GAS v2u*)(PB + (size_t)m * INCP + C_XG + c)); w.x = pk2(sigmoidf_(xg.x), sigmoidf_(xg.y)); w.y = pk2(sigmoidf_(xg.z), sigmoidf_(xg.w)); }
            *(GAS v2u*)(SGX + (size_t)m * 256 + c) = w; } }
        { FRESH_IDS
          for (int i = bx * 512 + tid; i < NTOK * 16; i += G * 512) { GAS v4u* q = (GAS v4u*)((bf16*)PB + (size_t)(i >> 4) * INCP + C_XW + (i & 15) * 8); const v4u x = *q;
              const f32x4 a = bf4_f32((v2u){x.x, x.y}), b = bf4_f32((v2u){x.z, x.w}); v4u o;
              o.x = pk2(tanh_fast(a.x), tanh_fast(a.y)); o.y = pk2(tanh_fast(a.z), tanh_fast(a.w)); o.z = pk2(tanh_fast(b.x), tanh_fast(b.y)); o.w = pk2(tanh_fast(b.z), tanh_fast(b.w)); *q = o; } }
        GRID_BAR(); RELAUNDER_L;

        for (int rep12_ = 0; rep12_ < REP_P4BC; ++rep12_) { if (rep12_) { GRID_BAR(); RELAUNDER_L; }
        for (int rep_ = 0; rep_ < REP_P4B; ++rep_) { if (rep_) { GRID_BAR(); RELAUNDER_L; }
        v4u pxw, pxa; v4u pw2, pa2; unsigned rr_raw[8], kr_raw[8], vr_raw[8]; float w0v, a0v, kkc, kac, rkc;
#define P4B_FETCH(uu_) do { const int d_ = (uu_) & 1, h_ = ((uu_) >> 1) & 15, R0_ = ((uu_) >> 5) * 64, ch_ = h_ * 64 + lane; \
            { const int tau_ = tid >> 3, r8_ = (tid & 7) * 8; const bf16* pr_ = PB + (size_t)(d_ ? R0_ + 63 - tau_ : R0_ + tau_) * INCP; \
              pxw = *(const GAS v4u*)(pr_ + C_XW + d_ * 64 + r8_); pxa = *(const GAS v4u*)(pr_ + C_XA + d_ * 64 + r8_); \
              const size_t wo_ = ((size_t)((l * 2 + d_) * 16 + h_) * 64 + tau_) * 64 + r8_; pw2 = *(const GAS v4u*)(W2TB + wo_); pa2 = *(const GAS v4u*)(A2TB + wo_); } \
            _Pragma("unroll") for (int e_ = 0; e_ < 8; ++e_) { const int tau_ = wave * 8 + e_; const bf16* pr_ = PB + (size_t)(d_ ? R0_ + 63 - tau_ : R0_ + tau_) * INCP; rr_raw[e_] = pr_[C_R + ch_]; kr_raw[e_] = pr_[C_K + ch_]; vr_raw[e_] = pr_[C_V + ch_]; } \
            w0v = INP(I_W0)[(l * 2 + d_) * 1024 + ch_]; a0v = INP(I_A0)[(l * 2 + d_) * 1024 + ch_]; kkc = INP(I_KK)[l * 1024 + ch_]; kac = INP(I_KA)[l * 1024 + ch_]; rkc = INP(I_RK)[l * 1024 + ch_]; } while (0)
        { FRESH_IDS P4B_FETCH(bx < 12288 ? bx : 0);
          asm volatile("" : "+v"(pxw), "+v"(pxa), "+v"(pw2), "+v"(pa2));
#pragma unroll
          for (int e = 0; e < 8; ++e) asm volatile("" : "+v"(rr_raw[e]), "+v"(kr_raw[e]), "+v"(vr_raw[e]));
          asm volatile("" : "+v"(w0v), "+v"(a0v), "+v"(kkc), "+v"(kac), "+v"(rkc)); }
        for (int u = bx; u < 12288; u += G) {
            FRESH_IDS
            const int d = u & 1, h = (u >> 1) & 15, cc = u >> 5, R0 = cc * 64;
            const int n = lane, g8 = wave * 8;
            LAS bf16* const SL = (LAS bf16*)(lds + RING_OFF);
#define SLOTP(s) (SL + (s) * (64 * LDB))
            LAS float* const SEG = (LAS float*)(lds + SEG_OFF);
            LAS float* const GC = SEG + 512;
            const int fr = lane & 15, fq = lane >> 4, wg = wave >> 2, i2 = (wave >> 1) & 1, j2 = wave & 1;
#define OI4(ii) (16 * (2 * i2 + (ii)) + fr)
#define OJ4(jj) (16 * (2 * j2 + (jj)) + 4 * fq)
#define FOR_T4 _Pragma("unroll") for (int ii = 0; ii < 2; ++ii) _Pragma("unroll") for (int jj = 0; jj < 2; ++jj)
#define ZERO4 {{{0.f, 0.f, 0.f, 0.f}, {0.f, 0.f, 0.f, 0.f}}, {{0.f, 0.f, 0.f, 0.f}, {0.f, 0.f, 0.f, 0.f}}}
            { const int tau = tid >> 3, r8 = (tid & 7) * 8; const bf16* pr = PB + (size_t)(d ? R0 + 63 - tau : R0 + tau) * INCP;
              *(LAS v4u*)(SLOTP(0) + tau * LDB + r8) = pxw;
              *(LAS v4u*)(SLOTP(1) + tau * LDB + r8) = pxa;
              *(LAS v4u*)(SLOTP(2) + tau * LDB + r8) = pw2;
              *(LAS v4u*)(SLOTP(3) + tau * LDB + r8) = pa2;
            }
            LBAR();
            { f32x4 a_[2][2] = ZERO4; mm_acc4(a_, wg ? SLOTP(1) : SLOTP(0), wg ? SLOTP(3) : SLOTP(2), i2, j2, fr, fq);
              LAS float* Fp = (LAS float*)(wg ? SLOTP(6) : SLOTP(4));
              FOR_T4 *(LAS f32x4*)(Fp + OI4(ii) * LDF + OJ4(jj)) = a_[ii][jj]; }
            LBAR();
            float lw[8], av[8], cl[8];
            { const LAS float* F1p = (const LAS float*)SLOTP(4); const LAS float* F2p = (const LAS float*)SLOTP(6); float run = 0.f;
#pragma unroll
              for (int e = 0; e < 8; ++e) { lw[e] = -0.60653066f * sigmoidf_(w0v + F1p[(g8 + e) * LDF + n]);       av[e] = sigmoidf_(a0v + F2p[(g8 + e) * LDF + n]); run += lw[e]; cl[e] = run; }
              SEG[wave * 64 + n] = run; }
            LBAR();
            for (int rep2_ = 0; rep2_ < REP_S2; ++rep2_) { if (rep2_) LBAR(); float off = 0.f, tot = 0.f;
#pragma unroll
              for (int w = 0; w < 8; ++w) { const float s = SEG[w * 64 + n]; tot += s; if (w < wave) off += s; }
              const float etot = __expf(tot); float pe = __expf(off); if (wave == 0) GC[n] = etot;
              float rr[8], kr[8], vr[8];
#pragma unroll
              for (int e = 0; e < 8; ++e) { unsigned a_ = rr_raw[e], b_ = kr_raw[e], c_ = vr_raw[e]; asm volatile("" : "+v"(a_), "+v"(b_), "+v"(c_)); rr[e] = __builtin_bit_cast(float, a_ << 16); kr[e] = __builtin_bit_cast(float, b_ << 16); vr[e] = __builtin_bit_cast(float, c_ << 16); }
              v4u pa, pb, pk, pv;
              float fta[8], ftb[8], ftk[8]; float bonv = 0.f;
#pragma unroll
              for (int e = 0; e < 8; ++e) { const int tau = g8 + e; const float c = cl[e] + off;
                  const float k1 = kr[e] * kkc; const float ssq = wave_sum(k1 * k1); const float kk = k1 * __builtin_amdgcn_rsqf(fmaxf(ssq, 1e-24f));
                  const float kd = kr[e] * (1.f + (av[e] - 1.f) * kac), bb = kk * av[e];
                  const float bon = wave_sum(rr[e] * kd * rkc);
                  bonv = (lane == e) ? bon : bonv;
                  const float ec = __expf(c), en = __builtin_amdgcn_rcpf(ec), ep = pe, eh = etot * en; pe = ec;
                  const float fa = kk * ep, fb = bb * en, fk = kd * en, fr_ = rr[e] * ec;
                  const unsigned w1_ = pk2(fa, fb), w2_ = pk2(fk, fr_);
                  SLOTP(4)[tau * LDB + n] = (bf16)(w1_ & 0xffffu); SLOTP(5)[tau * LDB + n] = (bf16)(w1_ >> 16); SLOTP(6)[tau * LDB + n] = (bf16)(w2_ & 0xffffu); SLOTP(7)[tau * LDB + n] = (bf16)(w2_ >> 16);
                  fta[e] = fa; ftb[e] = bb * eh; ftk[e] = kd * eh; }
              if (lane < 8) { const int tau = g8 + lane; BON[((size_t)d * NTOK + (d ? R0 + 63 - tau : R0 + tau)) * 16 + h] = bonv; }
              pa.x = pk2(fta[0], fta[1]); pa.y = pk2(fta[2], fta[3]); pa.z = pk2(fta[4], fta[5]); pa.w = pk2(fta[6], fta[7]);
              pb.x = pk2(ftb[0], ftb[1]); pb.y = pk2(ftb[2], ftb[3]); pb.z = pk2(ftb[4], ftb[5]); pb.w = pk2(ftb[6], ftb[7]);
              pk.x = pk2(ftk[0], ftk[1]); pk.y = pk2(ftk[2], ftk[3]); pk.z = pk2(ftk[4], ftk[5]); pk.w = pk2(ftk[6], ftk[7]);
              pv.x = pk2(vr[0], vr[1]); pv.y = pk2(vr[2], vr[3]); pv.z = pk2(vr[4], vr[5]); pv.w = pk2(vr[6], vr[7]);
              *(LAS v4u*)(SLOTP(8) + n * LDB + g8) = pa; *(LAS v4u*)(SLOTP(9) + n * LDB + g8) = pb; *(LAS v4u*)(SLOTP(10) + n * LDB + g8) = pk; *(LAS v4u*)(SLOTP(11) + n * LDB + g8) = pv; }
            { const int un_ = u + G < 12288 ? u + G : u; P4B_FETCH(un_); }
            LBAR();
#define WSYNC() asm volatile("s_waitcnt lgkmcnt(0)" ::: "memory")
            LAS bf16* const SLX = (LAS bf16*)(lds + SLOTX_OFF);
            { const f32x4 zf = {0.f, 0.f, 0.f, 0.f};
#define TILE16(X_, Y_, IT_, JT_, ACC_) do { _Pragma("unroll") for (int ks = 0; ks < 2; ++ks) { \
                    const pg8::bf16x8 bfr_ = *(const LAS pg8::bf16x8*)((X_) + (16 * (IT_) + fr) * LDB + 32 * ks + 8 * fq), afr_ = *(const LAS pg8::bf16x8*)((Y_) + (16 * (JT_) + fr) * LDB + 32 * ks + 8 * fq); \
                    ACC_ = __builtin_amdgcn_mfma_f32_16x16x32_bf16(afr_, bfr_, ACC_, 0, 0, 0); } } while (0)
              if (wave == 0) {
                LAS float* DBp = (LAS float*)(lds + DB_OFF);
#pragma unroll
                for (int b4 = 0; b4 < 4; ++b4) { f32x4 acc = zf; TILE16(SLOTP(4), SLOTP(5), b4, b4, acc);
#pragma unroll
                    for (int q = 0; q < 4; ++q) if (4 * fq + q >= fr) acc[q] = 0.f;
                    *(LAS f32x4*)(DBp + (b4 * 16 + fr) * DBLD + 4 * fq) = acc; }
                { const v4u zz = {0u, 0u, 0u, 0u};
#pragma unroll
                  for (int q = 0; q < 9; ++q) *(LAS v4u*)(SLX + lane * LDB + 8 * q) = zz; }
                const int blk = lane >> 4, cb = lane & 15; const LAS float* Lb = (const LAS float*)(lds + DB_OFF) + blk * 16 * DBLD; float Tc[16];
#define SOLVE_ROWS(I0_, NR_) do { f32x4 Lr[NR_][4]; \
                    _Pragma("unroll") for (int r = 0; r < NR_; ++r) _Pragma("unroll") for (int j4 = 0; j4 < ((I0_) + r + 3) / 4; ++j4) Lr[r][j4] = *(const LAS f32x4*)(Lb + ((I0_) + r) * DBLD + 4 * j4); \
                    WSYNC(); \
                    _Pragma("unroll") for (int r = 0; r < NR_; ++r) { const int i = (I0_) + r; float a0_ = (cb == i) ? 1.f : 0.f, a1_ = 0.f, a2_ = 0.f, a3_ = 0.f; \
                        _Pragma("unroll") for (int j4 = 0; j4 < (i + 3) / 4; ++j4) { const f32x4 Lv = Lr[r][j4]; \
                            if (4 * j4 + 0 < i) a0_ -= Lv.x * Tc[4 * j4 + 0]; if (4 * j4 + 1 < i) a1_ -= Lv.y * Tc[4 * j4 + 1]; if (4 * j4 + 2 < i) a2_ -= Lv.z * Tc[4 * j4 + 2]; if (4 * j4 + 3 < i) a3_ -= Lv.w * Tc[4 * j4 + 3]; } \
                        Tc[i] = (a0_ + a1_) + (a2_ + a3_); \
                        SLX[(16 * blk + i) * LDB + 16 * blk + cb] = (bf16)f2bf(Tc[i]); } } while (0)
                SOLVE_ROWS(0, 8); SOLVE_ROWS(8, 4); SOLVE_ROWS(12, 4);
#undef SOLVE_ROWS
                { v4u w0, w1; w0.x = pk2(Tc[0], Tc[1]); w0.y = pk2(Tc[2], Tc[3]); w0.z = pk2(Tc[4], Tc[5]); w0.w = pk2(Tc[6], Tc[7]); w1.x = pk2(Tc[8], Tc[9]); w1.y = pk2(Tc[10], Tc[11]); w1.z = pk2(Tc[12], Tc[13]); w1.w = pk2(Tc[14], Tc[15]);
                  const v4u zz = {0u, 0u, 0u, 0u};
#pragma unroll
                  for (int b = 0; b < 4; ++b) { *(LAS v4u*)(SLOTP(1) + lane * LDB + 16 * b) = (b == blk) ? w0 : zz; *(LAS v4u*)(SLOTP(1) + lane * LDB + 16 * b + 8) = (b == blk) ? w1 : zz; } }
              } else if (wave == 3) {
#define OFFD(IT_, JT_, DST_) do { f32x4 acc = zf; TILE16(SLOTP(4), SLOTP(5), IT_, JT_, acc); st_bf4((DST_) + (16 * (IT_) + fr) * LDB + 16 * (JT_) + 4 * fq, acc); } while (0)
                OFFD(1, 0, SLOTP(0)); OFFD(3, 2, SLOTP(0)); OFFD(2, 0, SLOTP(13)); OFFD(2, 1, SLOTP(13)); OFFD(3, 0, SLOTP(13)); OFFD(3, 1, SLOTP(13));
#undef OFFD
                st_bf4(SLOTP(0) + (16 + fr) * LDB + 16 + 4 * fq, zf); st_bf4(SLOTP(0) + (48 + fr) * LDB + 48 + 4 * fq, zf);
              } else {
                const bool lo = wave < 4, evn = (wave & 1) == 0; const int hi3 = (wave == 1 || wave == 4 || wave == 5) ? 1 : 0;
                const LAS bf16* Xp = lo ? SLOTP(4) : SLOTP(7); const LAS bf16* Yp = (!lo && evn) ? SLOTP(5) : SLOTP(6);
                LAS bf16* Op = lo ? SLOTP(2) : (evn ? SLOTP(3) : SLOTP(12)); const int mk = lo ? 1 : 0;
#pragma unroll
                for (int rr = 0; rr < 2; ++rr) { const int it = hi3 ? (rr ? 0 : 3) : (rr ? 1 : 2);
                    pg8::bf16x8 bfr[2];
#pragma unroll
                    for (int ks = 0; ks < 2; ++ks) bfr[ks] = *(const LAS pg8::bf16x8*)(Xp + (16 * it + fr) * LDB + 32 * ks + 8 * fq);
#pragma unroll
                    for (int jt = 0; jt < 4; ++jt) { f32x4 acc = zf;
                        if (jt <= it) {
#pragma unroll
                            for (int ks = 0; ks < 2; ++ks) acc = __builtin_amdgcn_mfma_f32_16x16x32_bf16(*(const LAS pg8::bf16x8*)(Yp + (16 * jt + fr) * LDB + 32 * ks + 8 * fq), bfr[ks], acc, 0, 0, 0);
                            if (jt == it) {
#pragma unroll
                                for (int q = 0; q < 4; ++q) if (4 * fq + q + mk > fr) acc[q] = 0.f; } }
                        st_bf4(Op + (16 * it + fr) * LDB + 16 * jt + 4 * fq, acc); } } }
#undef TILE16
            }
            LBAR();
            const int wq = wave & 3; const f32x4 zf4 = {0.f, 0.f, 0.f, 0.f};
            f32x4 pq[4] = {zf4, zf4, zf4, zf4}, py[4] = {zf4, zf4, zf4, zf4};
            pg8::bf16x8 gop[2] = {};
            if (wg == 1) {
                pg8::bf16x8 vb[2];
#pragma unroll
                for (int ks = 0; ks < 2; ++ks) vb[ks] = *(const LAS pg8::bf16x8*)(SLOTP(11) + (16 * wq + fr) * LDB + 32 * ks + 8 * fq);
                f32x4 g_[4] = {zf4, zf4, zf4, zf4};
#pragma unroll
                for (int jt = 0; jt < 4; ++jt)
#pragma unroll
                    for (int ks = 0; ks < 2; ++ks) if (ks == 0 || jt >= 2) g_[jt] = __builtin_amdgcn_mfma_f32_16x16x32_bf16(*(const LAS pg8::bf16x8*)(SLOTP(2) + (16 * jt + fr) * LDB + 32 * ks + 8 * fq), vb[ks], g_[jt], 0, 0, 0);
                gop[0] = pack_op(g_[0], g_[1]); gop[1] = pack_op(g_[2], g_[3]);
#pragma unroll
                for (int jt = 0; jt < 4; ++jt)
#pragma unroll
                    for (int ks = 0; ks < 2; ++ks) pq[jt] = __builtin_amdgcn_mfma_f32_16x16x32_bf16(*(const LAS pg8::bf16x8*)(SLOTP(10) + (16 * jt + fr) * LDB + 32 * ks + 8 * fq), vb[ks], pq[jt], 0, 0, 0);
#pragma unroll
                for (int it = 0; it < 4; ++it)
#pragma unroll
                    for (int ks = 0; ks < 2; ++ks) if (ks == 0 || it >= 2) py[it] = __builtin_amdgcn_mfma_f32_16x16x32_bf16(vb[ks], *(const LAS pg8::bf16x8*)(SLOTP(12) + (16 * it + fr) * LDB + 32 * ks + 8 * fq), py[it], 0, 0, 0);
            } else if (wave == 0) {
                { const v4u zz = {0u, 0u, 0u, 0u};
#pragma unroll
                  for (int q = 0; q < 9; ++q) *(LAS v4u*)(SLOTP(5) + lane * LDB + 8 * q) = zz; }
                WSYNC();
                const f32x4 z4 = {0.f, 0.f, 0.f, 0.f};
#pragma unroll
                for (int p = 0; p < 2; ++p) { const int bj = 2 * p, bk = 2 * p + 1, co = 32 * p + 8 * fq;
                    const pg8::bf16x8 bfr = *(const LAS pg8::bf16x8*)(SLOTP(1) + (16 * bj + fr) * LDB + co), afr = *(const LAS pg8::bf16x8*)(SLOTP(0) + (16 * bk + fr) * LDB + co);
                    st_bf4(SLOTP(5) + (16 * bj + fr) * LDB + 16 * bk + 4 * fq, __builtin_amdgcn_mfma_f32_16x16x32_bf16(afr, bfr, z4, 0, 0, 0)); }
                WSYNC();
#pragma unroll
                for (int p = 0; p < 2; ++p) { const int bi = 2 * p + 1, bj = 2 * p, co = 32 * p + 8 * fq;
                    const pg8::bf16x8 bfr = *(const LAS pg8::bf16x8*)(SLX + (16 * bi + fr) * LDB + co), afr = *(const LAS pg8::bf16x8*)(SLOTP(5) + (16 * bj + fr) * LDB + co);
                    const f32x4 ta = -__builtin_amdgcn_mfma_f32_16x16x32_bf16(afr, bfr, z4, 0, 0, 0); const unsigned p0 = pk2(ta.x, ta.y), p1 = pk2(ta.z, ta.w);
                    const int i_ = 16 * bi + fr, j_ = 16 * bj + 4 * fq;
                    *(LAS v2u*)(SLX + i_ * LDB + j_) = (v2u){p0, p1};
                    SLOTP(1)[(j_ + 0) * LDB + i_] = (bf16)(p0 & 0xffffu); SLOTP(1)[(j_ + 1) * LDB + i_] = (bf16)(p0 >> 16); SLOTP(1)[(j_ + 2) * LDB + i_] = (bf16)(p1 & 0xffffu); SLOTP(1)[(j_ + 3) * LDB + i_] = (bf16)(p1 >> 16); }
                WSYNC();
#pragma unroll
                for (int bj = 0; bj < 2; ++bj)
#pragma unroll
                    for (int bk = 2; bk < 4; ++bk) {
                        const pg8::bf16x8 bfr = *(const LAS pg8::bf16x8*)(SLOTP(1) + (16 * bj + fr) * LDB + 8 * fq), afr = *(const LAS pg8::bf16x8*)(SLOTP(13) + (16 * bk + fr) * LDB + 8 * fq);
                        st_bf4(SLOTP(5) + (16 * bj + fr) * LDB + 16 * bk + 4 * fq, __builtin_amdgcn_mfma_f32_16x16x32_bf16(afr, bfr, z4, 0, 0, 0)); }
                WSYNC();
#pragma unroll
                for (int bi = 2; bi < 4; ++bi)
#pragma unroll
                    for (int bj = 0; bj < 2; ++bj) {
                        const pg8::bf16x8 bfr = *(const LAS pg8::bf16x8*)(SLX + (16 * bi + fr) * LDB + 32 + 8 * fq), afr = *(const LAS pg8::bf16x8*)(SLOTP(5) + (16 * bj + fr) * LDB + 32 + 8 * fq);
                        st_bf4(SLX + (16 * bi + fr) * LDB + 16 * bj + 4 * fq, -__builtin_amdgcn_mfma_f32_16x16x32_bf16(afr, bfr, z4, 0, 0, 0)); }
            }
#undef WSYNC
            LBAR();
            if (wg == 0) {
                pg8::bf16x8 ab[2];
#pragma unroll
                for (int ks = 0; ks < 2; ++ks) ab[ks] = *(const LAS pg8::bf16x8*)(SLOTP(8) + (16 * wq + fr) * LDB + 32 * ks + 8 * fq);
                f32x4 w_[4] = {zf4, zf4, zf4, zf4};
#pragma unroll
                for (int jt = 0; jt < 4; ++jt)
#pragma unroll
                    for (int ks = 0; ks < 2; ++ks) if (ks == 0 || jt >= 2) w_[jt] = __builtin_amdgcn_mfma_f32_16x16x32_bf16(*(const LAS pg8::bf16x8*)(SLX + (16 * jt + fr) * LDB + 32 * ks + 8 * fq), ab[ks], w_[jt], 0, 0, 0);
                pg8::bf16x8 wop[2]; wop[0] = pack_op(w_[0], w_[1]); wop[1] = pack_op(w_[2], w_[3]);
#pragma unroll
                for (int it = 0; it < 4; ++it) { f32x4 ra = zf4, pa = zf4; const int oi = 16 * it + fr, oj = 16 * wq + 4 * fq;
#pragma unroll
                    for (int c = 0; c < 2; ++c) { if (c == 0 || it >= 2) ra = __builtin_amdgcn_mfma_f32_16x16x32_bf16(wop[c], ld_perm(SLOTP(3), oi, c, fq), ra, 0, 0, 0);
                        pa = __builtin_amdgcn_mfma_f32_16x16x32_bf16(wop[c], ld_perm(SLOTP(9), oi, c, fq), pa, 0, 0, 0); }
                    const float gci = GC[oi]; f32x4 pm = -pa;
#pragma unroll
                    for (int q = 0; q < 4; ++q) if (oj + q == oi) pm[q] += gci;
                    st_bf4(SLOTP(10) + oi * LDB + oj, bf4_f32(*(const LAS v2u*)(SLOTP(7) + oi * LDB + oj)) - ra); st_bf4(SLOTP(11) + oi * LDB + oj, pm); }
            } else {
                f32x4 u_[4] = {zf4, zf4, zf4, zf4};
#pragma unroll
                for (int jt = 0; jt < 4; ++jt)
#pragma unroll
                    for (int c = 0; c < 2; ++c) if (c == 0 || jt >= 2) u_[jt] = __builtin_amdgcn_mfma_f32_16x16x32_bf16(ld_perm(SLX, 16 * jt + fr, c, fq), gop[c], u_[jt], 0, 0, 0);
                pg8::bf16x8 uop[2]; uop[0] = pack_op(-u_[0], -u_[1]); uop[1] = pack_op(-u_[2], -u_[3]);
#pragma unroll
                for (int jt = 0; jt < 4; ++jt) {
#pragma unroll
                    for (int c = 0; c < 2; ++c) pq[jt] = __builtin_amdgcn_mfma_f32_16x16x32_bf16(ld_perm(SLOTP(9), 16 * jt + fr, c, fq), uop[c], pq[jt], 0, 0, 0);
                    st_bf4(SLOTP(12) + (16 * wq + fr) * LDB + 16 * jt + 4 * fq, pq[jt]); }
#pragma unroll
                for (int it = 0; it < 4; ++it) {
#pragma unroll
                    for (int c = 0; c < 2; ++c) if (c == 0 || it >= 2) py[it] = __builtin_amdgcn_mfma_f32_16x16x32_bf16(uop[c], ld_perm(SLOTP(3), 16 * it + fr, c, fq), py[it], 0, 0, 0);
                    st_bf4(SLOTP(13) + (16 * it + fr) * LDB + 16 * wq + 4 * fq, py[it]); }
            }
            LBAR();
            asm volatile("" : "+v"(pxw), "+v"(pxa), "+v"(pw2), "+v"(pa2));
#pragma unroll
            for (int e = 0; e < 8; ++e) asm volatile("" : "+v"(rr_raw[e]), "+v"(kr_raw[e]), "+v"(vr_raw[e]));
            asm volatile("" : "+v"(w0v), "+v"(a0v), "+v"(kkc), "+v"(kac), "+v"(rkc));
            { const int row = tid >> 3, ck = tid & 7; const size_t ub = (size_t)u * 4096 + row * 64 + ck * 8;
              *(GAS v4u*)(RHB + ub) = *(const LAS v4u*)(SLOTP(10) + row * LDB + ck * 8); *(GAS v4u*)(PMB + ub) = *(const LAS v4u*)(SLOTP(11) + row * LDB + ck * 8); *(GAS v4u*)(QTB + ub) = *(const LAS v4u*)(SLOTP(12) + row * LDB + ck * 8);
              *(GAS v4u*)(YLT + ub) = *(const LAS v4u*)(SLOTP(13) + row * LDB + ck * 8); }
#undef SLOTP
#undef OI4
#undef OJ4
#undef FOR_T4
#undef ZERO4
        }
#undef P4B_FETCH
        }
        GRID_BAR(); RELAUNDER_L;

        for (int tk = bx; tk < 256; tk += G) {
            FRESH_IDS
            const int wl = wave & 3, vt = wave >> 2, c = lane & 15, g = lane >> 4;
            const int smp = tk >> 7, tq = tk & 127, sp = (tq >> 4) * 8 + (tq & 7), vh = (tq >> 3) & 1, nch = smp ? 64 : 128,     d = (sp >> 4) & 1, h = sp & 15, cbase = seq_base((sp >> 5) + 2 * smp) >> 6;
            const int vcol = 32 * vh + 16 * vt + c;
            LAS bf16* const ZX = (LAS bf16*)(lds + RING_OFF);
            f32x4 Zc = {0.f, 0.f, 0.f, 0.f};
            struct PSet { pg8::bf16x8 O0, O1; v2u Qc; float Yl[4]; };
            PSet s0, s1, s2, s3, s4, s5, s6, s7;
            const bf16* const OWN = vt ? RHB : PMB;
            LAS v4u* const XB = (LAS v4u*)(lds + RING_OFF + 16384);
#define P4C_GEOM(kk_) const int kq_ = (kk_) < nch ? (kk_) : nch - 1; const int cc_ = cbase + (d ? nch - 1 - kq_ : kq_); \
                const size_t ub_ = ((size_t)((cc_ * 16 + h) * 2 + d)) * 4096; const size_t yb_ = ((size_t)d * NTOK + cc_ * 64) * 1024 + h * 64 + 32 * vh + 16 * vt + 4 * g; (void)ub_; (void)yb_;
#define P4C_LOAD(S_, kk_) do { P4C_GEOM(kk_) \
                S_.O0 = *(const pg8::bf16x8*)(OWN + ub_ + (16 * wl + c) * 64 + 8 * g); S_.O1 = *(const pg8::bf16x8*)(OWN + ub_ + (16 * wl + c) * 64 + 32 + 8 * g); \
                S_.Qc = *(const GAS v2u*)(QTB + ub_ + vcol * 64 + 16 * wl + 4 * g); \
                { const f32x4 yl_ = bf4_f32(*(const GAS v2u*)(YLT + ub_ + (16 * wl + c) * 64 + 32 * vh + 16 * vt + 4 * g)); S_.Yl[0] = yl_.x; S_.Yl[1] = yl_.y; S_.Yl[2] = yl_.z; S_.Yl[3] = yl_.w; } } while (0)
#define P4C_STEP(S_, kk_) do { P4C_GEOM(kk_) LAS bf16* zx = ZX + ((kk_) & 1) * (32 * LDB) + (16 * vt + c) * LDB; LAS v4u* xb = XB + ((kk_) & 1) * 1024; \
                st_bf4(zx + 16 * wl + 4 * g, Zc); \
                xb[(wave * 2 + 0) * 64 + lane] = __builtin_bit_cast(v4u, S_.O0); xb[(wave * 2 + 1) * 64 + lane] = __builtin_bit_cast(v4u, S_.O1); \
                LBAR(); \
                { const pg8::bf16x8 Zb0 = *(const LAS pg8::bf16x8*)(zx + 8 * g), Zb1 = *(const LAS pg8::bf16x8*)(zx + 32 + 8 * g); \
                    const pg8::bf16x8 X0 = __builtin_bit_cast(pg8::bf16x8, xb[((wave ^ 4) * 2 + 0) * 64 + lane]), X1 = __builtin_bit_cast(pg8::bf16x8, xb[((wave ^ 4) * 2 + 1) * 64 + lane]); \
                    const pg8::bf16x8 Pa0 = vt ? X0 : S_.O0, Pa1 = vt ? X1 : S_.O1, Ra0 = vt ? S_.O0 : X0, Ra1 = vt ? S_.O1 : X1; \
                    f32x4 ya = {S_.Yl[0], S_.Yl[1], S_.Yl[2], S_.Yl[3]}; \
                    ya = __builtin_amdgcn_mfma_f32_16x16x32_bf16(Zb0, Ra0, ya, 0, 0, 0); ya = __builtin_amdgcn_mfma_f32_16x16x32_bf16(Zb1, Ra1, ya, 0, 0, 0);     \
                    f32x4 za = bf4_f32(S_.Qc); \
                    za = __builtin_amdgcn_mfma_f32_16x16x32_bf16(Pa0, Zb0, za, 0, 0, 0); za = __builtin_amdgcn_mfma_f32_16x16x32_bf16(Pa1, Zb1, za, 0, 0, 0); \
                    Zc = za; \
                    { const int t_ = 16 * wl + c; v2u yw_; yw_.x = pk2(ya[0], ya[1]); yw_.y = pk2(ya[2], ya[3]); *(GAS v2u*)(YB + yb_ + (size_t)(d ? 63 - t_ : t_) * 1024) = yw_; } } } while (0)
            P4C_LOAD(s0, 0); P4C_LOAD(s1, 1); P4C_LOAD(s2, 2); P4C_LOAD(s3, 3); P4C_LOAD(s4, 4); P4C_LOAD(s5, 5); P4C_LOAD(s6, 6); P4C_LOAD(s7, 7);
            for (int k = 0; k < nch; k += 8) {
                P4C_STEP(s0, k);     P4C_LOAD(s0, k + 8);
                P4C_STEP(s1, k + 1); P4C_LOAD(s1, k + 9);
                P4C_STEP(s2, k + 2); P4C_LOAD(s2, k + 10);
                P4C_STEP(s3, k + 3); P4C_LOAD(s3, k + 11);
                P4C_STEP(s4, k + 4); P4C_LOAD(s4, k + 12);
                P4C_STEP(s5, k + 5); P4C_LOAD(s5, k + 13);
                P4C_STEP(s6, k + 6); P4C_LOAD(s6, k + 14);
                P4C_STEP(s7, k + 7); P4C_LOAD(s7, k + 15);
            }
#undef P4C_STEP
#undef P4C_LOAD
#undef P4C_GEOM
            LBAR();
        } }
        __syncthreads(); RELAUNDER_L;
        if (G < 256 || bx >= 128) {
            const int Gs = G >= 256 ? 128 : G, cs = G >= 256 ? bx - 128 : bx;
            pg8::Gemm g{POOLED, POOLW + (size_t)l * 1024 * 256, NTOK, 1024, 256, 1024, 256, 256}; pg8::StaticOrder S; S.init(NTOK, 1024, Gs, cs);
            pg8::EpiBf16<0> E{MIX + 1024, DM, INP(I_POOLS) + l * 1024};
            pg8::gemm_phase<pg8::EpiBf16<0>, pg8::StaticOrder, true>(lds + RING_OFF, g, S, E);
            pg8::Gemm g2_{SGX, G2TB + (size_t)l * 1024 * 256, NTOK, 1024, 256, 256, 256, 0}; pg8::StaticOrder S2_; S2_.init(NTOK, 1024, Gs, cs);
            pg8::EpiBf16<0> E2_{GATE, 1024, nullptr};
            pg8::gemm_phase<pg8::EpiBf16<0>, pg8::StaticOrder, true>(lds + RING_OFF, g2_, S2_, E2_);
        }
        GRID_BAR(); RELAUNDER_L;

        for (int rep_ = 0; rep_ < REP_P6; ++rep_) { if (rep_) { GRID_BAR(); RELAUNDER_L; }
            FRESH_IDS
            const int half = wave & 1, tsel = wave >> 1, chn = 512 * half + 8 * lane, hd = 8 * half + (lane >> 3);
            const f32x4 lw0 = *(const f32x4*)(INP(I_LNW) + l * 1024 + chn), lw1 = *(const f32x4*)(INP(I_LNW) + l * 1024 + chn + 4), lb0 = *(const f32x4*)(INP(I_LNB) + l * 1024 + chn), lb1 = *(const f32x4*)(INP(I_LNB) + l * 1024 + chn + 4);
#pragma unroll 4
            for (int m = bx * 4 + tsel; m < NTOK; m += 4 * G) {
                const v4u ya = *(const GAS v4u*)(YB + (size_t)m * 1024 + chn), yb = *(const GAS v4u*)(YB + ((size_t)NTOK + m) * 1024 + chn);
                const v4u vx = *(const GAS v4u*)(PB + (size_t)m * INCP + C_V + chn), gw = *(const GAS v4u*)(GATE + (size_t)m * 1024 + chn);
                const float bo = BON[(size_t)m * 16 + hd] + BON[((size_t)NTOK + m) * 16 + hd];
                const f32x4 y0 = bf4_f32((v2u){ya.x, ya.y}) + bf4_f32((v2u){yb.x, yb.y}), y1 = bf4_f32((v2u){ya.z, ya.w}) + bf4_f32((v2u){yb.z, yb.w});
                const float mu = red8(((y0.x + y0.y) + (y0.z + y0.w)) + ((y1.x + y1.y) + (y1.z + y1.w))) * (1.f / 64.f); const f32x4 d0 = y0 - mu, d1 = y1 - mu;
                const float var = red8(((d0.x * d0.x + d0.y * d0.y) + (d0.z * d0.z + d0.w * d0.w)) + ((d1.x * d1.x + d1.y * d1.y) + (d1.z * d1.z + d1.w * d1.w))) * (1.f / 64.f); const float rs = __builtin_amdgcn_rsqf(var + GN_EPS);
                const f32x4 o0 = (d0 * rs * lw0 + lb0 + bo * bf4_f32((v2u){vx.x, vx.y})) * bf4_f32((v2u){gw.x, gw.y}), o1 = (d1 * rs * lw1 + lb1 + bo * bf4_f32((v2u){vx.z, vx.w})) * bf4_f32((v2u){gw.z, gw.w});
                v4u w; w.x = pk2(o0.x, o0.y); w.y = pk2(o0.z, o0.w); w.z = pk2(o1.x, o1.y); w.w = pk2(o1.z, o1.w);
                *(GAS v4u*)(MIX + (size_t)m * DM + chn) = w;
            }
        }
        GRID_BAR(); RELAUNDER_L;

        { pg8::Gemm g{MIX, WOUTT + (size_t)l * DM * DM, NTOK, DM, DM, DM, DM, 0}; pg8::StaticOrder S; S.init(NTOK, DM, G, bx);
          pg8::EpiResGate E{l == 0 ? INP(I_XP) : nullptr, l == 0 ? INP(I_XS) - (size_t)16384 * DM : nullptr, XR, modl + 2 * 2048};
          pg8::gemm_phase<pg8::EpiResGate, pg8::StaticOrder, true>(lds + RING_OFF, g, S, E); }
        GRID_BAR(); RELAUNDER_L;

        NORM_PHASE_BF(INP(I_N2G) + l * DM, 3, 4);
        GRID_BAR(); RELAUNDER_L;

        for (int rep_ = 0; rep_ < REP_P9; ++rep_) { if (rep_) { GRID_BAR(); RELAUNDER_L; } pg8::Gemm g{HB, W1T + (size_t)l * DFF * DM, NTOK, DFF, DM, DM, DM, 0}; pg8::StaticOrder S; S.init(NTOK, DFF, G, bx);
          pg8::EpiBf16<1> E{F1, DFF, nullptr};
          pg8::gemm_phase<pg8::EpiBf16<1>, pg8::StaticOrder, true>(lds + RING_OFF, g, S, E); }
        GRID_BAR(); RELAUNDER_L;

        { pg8::Gemm g{F1, W2T + (size_t)l * DM * DFF, NTOK, DM, DFF, DFF, DFF, 0}; pg8::StaticOrder S; S.init(NTOK, DM, G, bx);
          pg8::EpiResGate E{nullptr, nullptr, XR, modl + 5 * 2048};
          pg8::gemm_phase<pg8::EpiResGate, pg8::StaticOrder, true>(lds + RING_OFF, g, S, E); }
        GRID_BAR(); RELAUNDER_L;
    }

    FRESH_IDS
    { f32x4 fgv[8];
#pragma unroll
      for (int j = 0; j < 4; ++j) { fgv[2 * j] = *(const f32x4*)(INP(I_FG) + 8 * lane + 512 * j); fgv[2 * j + 1] = *(const f32x4*)(INP(I_FG) + 8 * lane + 512 * j + 4); }
      for (int m0 = gw; m0 < NTOK; m0 += 2 * NGW) { const bool two = m0 + NGW < NTOK; const int m1 = two ? m0 + NGW : m0;
        v4u wa[4], wb[4];
#pragma unroll
        for (int j = 0; j < 4; ++j) { wa[j] = *(const GAS v4u*)(XR + (size_t)m0 * DM + 8 * lane + 512 * j); wb[j] = *(const GAS v4u*)(XR + (size_t)m1 * DM + 8 * lane + 512 * j); }
#pragma unroll
        for (int rr = 0; rr < 2; ++rr) { if (rr == 1 && !two) break; float* orow = out + (size_t)(rr ? m1 : m0) * DM;
            f32x4 v[8]; float ss = 0.f;
#pragma unroll
            for (int j = 0; j < 4; ++j) { const v4u w = rr ? wb[j] : wa[j]; v[2 * j] = bf4_f32((v2u){w.x, w.y}); v[2 * j + 1] = bf4_f32((v2u){w.z, w.w}); }
#pragma unroll
            for (int j = 0; j < 8; ++j) ss += (v[j].x * v[j].x + v[j].y * v[j].y) + (v[j].z * v[j].z + v[j].w * v[j].w);
            const float rs = 1.0f / sqrtf(wave_sum(ss) * (1.f / DM) + NORM_EPS);
#pragma unroll
            for (int j = 0; j < 4; ++j) { const int c = 8 * lane + 512 * j; *(f32x4*)(orow + c) = v[2 * j] * rs * fgv[2 * j]; *(f32x4*)(orow + c + 4) = v[2 * j + 1] * rs * fgv[2 * j + 1]; } } } }
}

extern "C" void kernel_launch(void* const* d_in, const int* in_sizes, int n_in, void* d_out, int out_size, void* d_ws, size_t ws_size, hipStream_t stream) {
    static int grid = 0;
    if (grid == 0) {
        if (n_in != 25 || out_size != NTOK * DM || ws_size < WS_END) { fprintf(stderr, "kernel_launch: unexpected shapes (n_in %d, out %d, ws %zu); nothing launched\n", n_in, out_size, ws_size); grid = -1; return; }
        int dev = 0, cus = 0, per_cu = 0;
        if (hipGetDevice(&dev) != hipSuccess || hipDeviceGetAttribute(&cus, hipDeviceAttributeMultiprocessorCount, dev) != hipSuccess) { grid = -1; return; }
        if (hipFuncSetAttribute((const void*)hymba_fwd, hipFuncAttributeMaxDynamicSharedMemorySize, LDS_BYTES) != hipSuccess) { fprintf(stderr, "kernel_launch: hipFuncSetAttribute failed\n"); grid = -1; return; }
        if (hipOccupancyMaxActiveBlocksPerMultiprocessor(&per_cu, (const void*)hymba_fwd, NWAVES * 64, LDS_BYTES) != hipSuccess || per_cu < 1) { fprintf(stderr, "kernel_launch: occupancy query reports %d\n", per_cu); }
        (void)hipGetLastError();
        grid = cus;
    }
    if (grid < 0) return;
    if (hipMemsetAsync((char*)d_ws + WS_CTL, 0, CTL_ZERO_BYTES, stream) != hipSuccess) return;
    Args a{};
    for (int i = 0; i < 25; ++i) a.in[i] = (const float*)d_in[i];
    a.out = (float*)d_out; a.ws = (unsigned char*)d_ws;
    hipLaunchKernelGGL(hymba_fwd, dim3(grid), dim3(NWAVES * 64), LDS_BYTES, stream, a);
}
```

```cpp
#include <hip/hip_runtime.h>
#include <cstdio>
#include <cstdint>
#ifndef REP_P2
#define REP_P2 1
#endif
#ifndef REP_P4B
#define REP_P4B 1
#endif
#ifndef REP_S2
#define REP_S2 1
#endif
#ifndef REP_P9
#define REP_P9 1
#endif
#ifndef REP_P4BC
#define REP_P4BC 1
#endif
#ifndef REP_P0
#define REP_P0 1
#endif
#ifndef REP_MISC
#define REP_MISC 1
#endif
#ifndef REP_P6
#define REP_P6 1
#endif

namespace pg8 {
#define PG8_LAS __attribute__((address_space(3)))
typedef unsigned short bf16_t;
typedef short bf16x8 __attribute__((ext_vector_type(8)));
typedef float f32x4 __attribute__((ext_vector_type(4)));
typedef unsigned u32x4 __attribute__((ext_vector_type(4)));
constexpr int BM = 256, BK = 64, HALF = 128, HTB = HALF * BK * 2, STAGE_BYTES = 8 * HTB, NXCD = 8, WGM = 8;

__host__ __device__ __forceinline__ int lds_byte(int r, int c) { const int st = (r >> 4) * 2 + (c >> 5), rr = r & 15, cc = c & 31, ob = rr * 64 + cc * 2; return st * 1024 + (ob ^ (((ob >> 9) & 1) << 5)); }
__host__ __device__ __forceinline__ void stage_rc(int b, int& R, int& C) { const int st = b / 1024, sb = b % 1024, swz = sb ^ (((sb >> 9) & 1) << 5); R = (st >> 1) * 16 + swz / 64; C = (st & 1) * 32 + (swz % 64) / 2; }
__host__ __device__ __forceinline__ int perm32(int rho) { const int n = rho >> 4, i = rho & 15; return 8 * (i >> 2) + 4 * n + (i & 3); }

struct Unit { int pm, pn; };
struct Gemm { const bf16_t* A; const bf16_t* Bt; int M, N, K, lda, ldb, apn; };

struct StaticOrder {
    int nM, nN, nwg, G, c;
    __host__ __device__ void init(int M, int N, int G_, int c_) { nM = M / BM; nN = N / BM; nwg = nM * nN; G = G_; c = c_; }
    __host__ __device__ bool next(int i, Unit& u) const {
        const long L = (long)i * G + c; if (L >= nwg || c < 0) return false;
        int wgid = (int)L; { const int q = nwg / NXCD, r = nwg % NXCD, xcd = wgid % NXCD, off = wgid / NXCD; wgid = (xcd < r ? xcd * (q + 1) : r * (q + 1) + (xcd - r) * q) + off; }
        const int nig = WGM * nN, gid = wgid / nig, fm = gid * WGM, gsz = (nM - fm) < WGM ? (nM - fm) : WGM;
        u.pm = fm + ((wgid % nig) % gsz); u.pn = (wgid % nig) / gsz; return true;
    }
    __device__ __forceinline__ void a_ready(const Unit&) const {}
    __device__ __forceinline__ void done(const Unit&) const {}
};

typedef float f32x2c __attribute__((ext_vector_type(2))); typedef __bf16 bf16x2c __attribute__((ext_vector_type(2)));
__device__ __forceinline__ unsigned cvt_pk_bf16(float lo, float hi) { const f32x2c v = {lo, hi}; const bf16x2c b = __builtin_convertvector(v, bf16x2c); return __builtin_bit_cast(unsigned, b); }

struct EpiF32 {
    static constexpr bool PERM = false;
    float* C; int ldc;
    __device__ __forceinline__ void operator()(const f32x4 (&acc)[2][2][4][2], const Unit& u, int wr, int wc, int fr, int fq) const {
        const int row0 = u.pm * BM + wr * 64 + fr, col0 = u.pn * BM + wc * 32 + 4 * fq;
#pragma unroll
        for (int ai = 0; ai < 2; ++ai)
#pragma unroll
            for (int m = 0; m < 4; ++m) { float* rowp = C + (size_t)(row0 + ai * HALF + m * 16) * ldc + col0;
#pragma unroll
                for (int bj = 0; bj < 2; ++bj)
#pragma unroll
                    for (int n = 0; n < 2; ++n) *(f32x4*)(rowp + bj * HALF + n * 16) = acc[ai][bj][m][n]; }
    }
};
struct EpiResGate {
    static constexpr bool PERM = true;
    const float* srcf0; const float* srcf1; bf16_t* xr; const float* gate;
    __device__ __forceinline__ void operator()(const f32x4 (&acc)[2][2][4][2], const Unit& u, int wr, int wc, int, int) const {
        int ln = threadIdx.x; asm volatile("" : "+v"(ln)); const int fr = ln & 15, fq = (ln & 63) >> 4;
        const int rowt = u.pm * BM; const int sq = rowt < 16384 ? (rowt >> 13) : 2 + ((rowt - 16384) >> 12);
        const float* srcf = rowt < 16384 ? srcf0 : srcf1; const float* gp = gate + sq * 12288;
        const int row0 = rowt + wr * 64 + fr, col0 = u.pn * BM + wc * 32 + 8 * fq;
#pragma unroll
        for (int bj = 0; bj < 2; ++bj) { const f32x4 g0 = *(const f32x4*)(gp + col0 + bj * HALF), g1 = *(const f32x4*)(gp + col0 + bj * HALF + 4);
#pragma unroll
            for (int ai = 0; ai < 2; ++ai)
#pragma unroll
                for (int m = 0; m < 4; ++m) { const size_t off = (size_t)(row0 + ai * HALF + m * 16) * 2048 + col0 + bj * HALF;
                    f32x4 x0, x1;
                    if (srcf0) { x0 = *(const f32x4*)(srcf + off); x1 = *(const f32x4*)(srcf + off + 4); }
                    else { const u32x4 w = *(const u32x4*)(xr + off);
                        x0[0] = __builtin_bit_cast(float, w.x << 16); x0[1] = __builtin_bit_cast(float, w.x & 0xffff0000u); x0[2] = __builtin_bit_cast(float, w.y << 16); x0[3] = __builtin_bit_cast(float, w.y & 0xffff0000u);
                        x1[0] = __builtin_bit_cast(float, w.z << 16); x1[1] = __builtin_bit_cast(float, w.z & 0xffff0000u); x1[2] = __builtin_bit_cast(float, w.w << 16); x1[3] = __builtin_bit_cast(float, w.w & 0xffff0000u); }
                    const f32x4 o0 = x0 + g0 * acc[ai][bj][m][0], o1 = x1 + g1 * acc[ai][bj][m][1];
                    u32x4 ow; ow.x = cvt_pk_bf16(o0[0], o0[1]); ow.y = cvt_pk_bf16(o0[2], o0[3]); ow.z = cvt_pk_bf16(o1[0], o1[1]); ow.w = cvt_pk_bf16(o1[2], o1[3]);
                    *(u32x4*)(xr + off) = ow; } }
    }
};
template <int ACT> struct EpiBf16 {
    static constexpr bool PERM = true;
    bf16_t* O; int ldc; const float* scale;
    __device__ __forceinline__ void operator()(const f32x4 (&acc)[2][2][4][2], const Unit& u, int wr, int wc, int, int) const {
        int ln = threadIdx.x; asm volatile("" : "+v"(ln)); const int fr = ln & 15, fq = (ln & 63) >> 4;
        const int row0 = u.pm * BM + wr * 64 + fr; const int col0 = u.pn * BM + wc * 32 + 8 * fq;
#pragma unroll
        for (int ai = 0; ai < 2; ++ai)
#pragma unroll
            for (int m = 0; m < 4; ++m) { bf16_t* rowp = O + (size_t)(row0 + ai * HALF + m * 16) * ldc + col0;
#pragma unroll
                for (int bj = 0; bj < 2; ++bj) { f32x4 v0 = acc[ai][bj][m][0], v1 = acc[ai][bj][m][1];
                    if (ACT == 1) {
#pragma unroll
                        for (int q = 0; q < 4; ++q) { v0[q] = __builtin_amdgcn_fmed3f(v0[q], 0.f, 3.0e38f); v1[q] = __builtin_amdgcn_fmed3f(v1[q], 0.f, 3.0e38f); }
                        v0 = v0 * v0; v1 = v1 * v1; }
                    if (scale) { v0 = v0 * *(const f32x4*)(scale + col0 + bj * HALF); v1 = v1 * *(const f32x4*)(scale + col0 + bj * HALF + 4); }
                    u32x4 w; w.x = cvt_pk_bf16(v0[0], v0[1]); w.y = cvt_pk_bf16(v0[2], v0[3]); w.z = cvt_pk_bf16(v1[0], v1[1]); w.w = cvt_pk_bf16(v1[2], v1[3]);
                    *(u32x4*)(rowp + bj * HALF) = w; } }
    }
};

template <class Epi, class Sched, bool ALIGN_EPI = false>
__device__ __forceinline__ void gemm_phase(PG8_LAS unsigned char* lds, const Gemm g, const Sched& S, const Epi& E) {
    int tid = threadIdx.x; asm volatile("" : "+v"(tid));
    const int wid = __builtin_amdgcn_readfirstlane(tid >> 6), lane = tid & 63, wr = wid >> 2, wc = wid & 3, fr = lane & 15, fq = lane >> 4;
    const int K = g.K, nt = K / BK;
    unsigned voffA[2], voffB[2];
#pragma unroll
    for (int i = 0; i < 2; ++i) { int R, C; stage_rc(tid * 16 + i * 8192, R, C); const int Rb = Epi::PERM ? ((R & ~31) + perm32(R & 31)) : R;
        voffA[i] = (unsigned)(R * g.lda + C) * 2u; voffB[i] = (unsigned)(Rb * g.ldb + C) * 2u; }
    const size_t kstep = (size_t)(BK * 2);
    const size_t hsA = (size_t)HALF * g.lda * 2, hsB = (size_t)HALF * g.ldb * 2;
    const size_t tsA = 2 * hsA, tsB = 2 * hsB;
    const unsigned ldsw = (unsigned)wid * 1024u;
    const int aoff = lds_byte(wr * 64 + fr, fq * 8), boff = lds_byte(wc * 32 + fr, fq * 8);
#define PG8_SA(b, h) (((b) * 2 + (h)) * HTB)
#define PG8_SB(b, h) ((4 + (b) * 2 + (h)) * HTB)
#define PG8_STAGE(bufoff, gbase, voff) do { _Pragma("unroll") for (int _i = 0; _i < 2; ++_i) \
        __builtin_amdgcn_global_load_lds((const unsigned*)((const char*)(gbase) + (voff)[_i]), (PG8_LAS unsigned*)(lds + (bufoff) + ldsw + _i * 8192), 16, 0, 0); } while (0)
#define PG8_LDA(dst, b, h) do { _Pragma("unroll") for (int m = 0; m < 4; ++m) _Pragma("unroll") for (int k = 0; k < 2; ++k) dst[m][k] = *(const PG8_LAS bf16x8*)(lds + PG8_SA(b, h) + aoff + m * 2048 + k * 1024); } while (0)
#define PG8_LDB(dst, b, h) do { _Pragma("unroll") for (int n = 0; n < 2; ++n) _Pragma("unroll") for (int k = 0; k < 2; ++k) dst[n][k] = *(const PG8_LAS bf16x8*)(lds + PG8_SB(b, h) + boff + n * 2048 + k * 1024); } while (0)
#define PG8_MMA(ai, bj, At, Bt) do { __builtin_amdgcn_s_setprio(1); _Pragma("unroll") for (int m = 0; m < 4; ++m) _Pragma("unroll") for (int n = 0; n < 2; ++n) _Pragma("unroll") for (int k = 0; k < 2; ++k) \
        acc[ai][bj][m][n] = __builtin_amdgcn_mfma_f32_16x16x32_bf16(Bt[n][k], At[m][k], acc[ai][bj][m][n], 0, 0, 0); __builtin_amdgcn_s_setprio(0); } while (0)
#define PG8_WAIT_V(n) asm volatile("s_waitcnt vmcnt(" #n ")" ::: "memory")
#define PG8_WAIT_L(n) asm volatile("s_waitcnt lgkmcnt(" #n ")" ::: "memory")
#define PG8_BAR __builtin_amdgcn_s_barrier()
#define PG8_SCHED __builtin_amdgcn_sched_barrier(0)
    Unit cur, nxt; int ui = 0;
    if (!S.next(0, cur)) return;
    f32x4 acc[2][2][4][2];
#pragma unroll
    for (int a = 0; a < 2; ++a)
#pragma unroll
        for (int b = 0; b < 2; ++b)
#pragma unroll
            for (int m = 0; m < 4; ++m)
#pragma unroll
                for (int n = 0; n < 2; ++n) acc[a][b][m][n] = (f32x4){0.f, 0.f, 0.f, 0.f};
    bf16x8 At[4][2], B0[2][2], B1[2][2];
    const char* cA = (const char*)g.A + (size_t)cur.pm * tsA + (size_t)cur.pn * g.apn * 2; const char* cB = (const char*)g.Bt + (size_t)cur.pn * tsB;
    S.a_ready(cur);
    PG8_STAGE(PG8_SB(0, 0), cB, voffB); PG8_STAGE(PG8_SB(0, 1), cB + hsB, voffB); PG8_STAGE(PG8_SA(0, 0), cA, voffA); PG8_STAGE(PG8_SA(0, 1), cA + hsA, voffA);
    if (wr == 1) PG8_BAR;
    PG8_WAIT_V(2); PG8_BAR;
    PG8_STAGE(PG8_SB(1, 0), cB + kstep, voffB); PG8_STAGE(PG8_SA(1, 0), cA + kstep, voffA); PG8_STAGE(PG8_SB(1, 1), cB + hsB + kstep, voffB);
    PG8_WAIT_V(6); PG8_BAR;
    for (;;) {
        const bool has_next = S.next(ui + 1, nxt);
        const char* nA = has_next ? (const char*)g.A + (size_t)nxt.pm * tsA + (size_t)nxt.pn * g.apn * 2 : cA; const char* nB = has_next ? (const char*)g.Bt + (size_t)nxt.pn * tsB : cB;
        for (int t = 0; t < nt; t += 2) {
            const bool last = (t == nt - 2);
            const char* a1 = cA + (size_t)(t + 1) * kstep;
            const char* a2 = last ? nA : cA + (size_t)(t + 2) * kstep; const char* b2 = last ? nB : cB + (size_t)(t + 2) * kstep;
            const char* a3 = a2 + kstep; const char* b3 = b2 + kstep;
            if (last && has_next) S.a_ready(nxt);
            PG8_LDB(B0, 0, 0); PG8_LDB(B1, 0, 1); PG8_SCHED; PG8_LDA(At, 0, 0); PG8_STAGE(PG8_SA(1, 1), a1 + hsA, voffA);
            PG8_WAIT_V(8); PG8_WAIT_L(0); PG8_BAR; PG8_MMA(0, 0, At, B0); PG8_MMA(0, 1, At, B1); PG8_BAR; PG8_SCHED;
            PG8_LDA(At, 0, 1); PG8_STAGE(PG8_SB(0, 0), b2, voffB); PG8_STAGE(PG8_SB(0, 1), b2 + hsB, voffB); PG8_STAGE(PG8_SA(0, 0), a2, voffA);
            PG8_WAIT_V(8); PG8_WAIT_L(0); PG8_BAR; PG8_MMA(1, 0, At, B0); PG8_MMA(1, 1, At, B1); PG8_BAR; PG8_SCHED;
            PG8_LDB(B0, 1, 0); PG8_LDB(B1, 1, 1); PG8_SCHED; PG8_LDA(At, 1, 0); PG8_STAGE(PG8_SA(0, 1), a2 + hsA, voffA);
            PG8_WAIT_V(8); PG8_WAIT_L(0); PG8_BAR; PG8_MMA(0, 0, At, B0); PG8_MMA(0, 1, At, B1); PG8_BAR; PG8_SCHED;
            PG8_LDA(At, 1, 1); PG8_STAGE(PG8_SB(1, 0), b3, voffB); PG8_STAGE(PG8_SB(1, 1), b3 + hsB, voffB); PG8_STAGE(PG8_SA(1, 0), a3, voffA);
            PG8_WAIT_V(8); PG8_WAIT_L(0); PG8_BAR; PG8_MMA(1, 0, At, B0); PG8_MMA(1, 1, At, B1); PG8_BAR; PG8_SCHED;
        }
        if constexpr (ALIGN_EPI) { if (wr == 0) PG8_BAR; }
        E(acc, cur, wr, wc, fr, fq); S.done(cur);
        if (!has_next) break;
#pragma unroll
        for (int a = 0; a < 2; ++a)
#pragma unroll
            for (int b = 0; b < 2; ++b)
#pragma unroll
                for (int m = 0; m < 4; ++m)
#pragma unroll
                    for (int n = 0; n < 2; ++n) acc[a][b][m][n] = (f32x4){0.f, 0.f, 0.f, 0.f};
        cur = nxt; cA = nA; cB = nB; ++ui;
        if constexpr (ALIGN_EPI) { if (wr == 1) PG8_BAR; }
    }
    PG8_WAIT_V(0);
    if constexpr (!ALIGN_EPI) { if (wr == 0) PG8_BAR; }
    PG8_BAR;
#undef PG8_SA
#undef PG8_SB
#undef PG8_STAGE
#undef PG8_LDA
#undef PG8_LDB
#undef PG8_MMA
#undef PG8_WAIT_V
#undef PG8_WAIT_L
#undef PG8_BAR
#undef PG8_SCHED
}
}

constexpr int NWAVES = 8;
constexpr int DM = 2048, NTOK = 24576, DEPTH = 4, INC = 4512, INCP = 4608, DFF = 8192, RW = 1024, NH = 16, HD = 64;
constexpr int C_R = 0, C_K = 1024, C_V = 2048, C_XW = 3072, C_XA = 3200, C_XG = 3328, C_U = 3488;
constexpr float NORM_EPS = 1e-6f, GN_EPS = 64e-5f;
__device__ __forceinline__ int seq_of_row(int m) { return m < 16384 ? (m >> 13) : 2 + ((m - 16384) >> 12); }
__device__ __forceinline__ int seq_base(int s) { return s < 2 ? s * 8192 : 16384 + (s - 2) * 4096; }
__device__ __forceinline__ int seq_len(int s) { return s < 2 ? 8192 : 4096; }

constexpr size_t MiB = 1u << 20;
constexpr size_t WS_CTL = 0, CTL_ZERO_BYTES = 1 * MiB;
constexpr size_t WS_MOD = 1 * MiB;
constexpr size_t WS_BON = 2 * MiB;
constexpr size_t WS_POOLW = 6 * MiB;
constexpr size_t WS_WIN = 8 * MiB;
constexpr size_t WS_WOUT = 80 * MiB;
constexpr size_t WS_W1 = 112 * MiB;
constexpr size_t WS_W2 = 240 * MiB;
constexpr size_t WS_H = 368 * MiB;
constexpr size_t WS_MIX = 464 * MiB;
constexpr size_t WS_POOLED = 560 * MiB;
constexpr size_t WS_Y = 608 * MiB;
constexpr size_t WS_P = 800 * MiB;
constexpr size_t WS_F1 = 800 * MiB;
constexpr size_t WS_PM = 1196 * MiB;
constexpr size_t WS_QT = 1292 * MiB;
constexpr size_t WS_RH = 368 * MiB;
constexpr size_t WS_W2T = 1388 * MiB, WS_A2T = 1389 * MiB;
constexpr size_t WS_GATE = 1390 * MiB;
constexpr size_t WS_G2T = 1438 * MiB;
constexpr size_t WS_SGX = 1184 * MiB;
constexpr size_t WS_XR = 704 * MiB;
constexpr size_t WS_YLT = 1016 * MiB;
constexpr size_t WS_END = 1440 * MiB;
constexpr int CW_TMO = 0, CW_BAR = 4096;
constexpr size_t WS_SCR = 512 * 1024;

constexpr int RING_OFF = 0, RING_BYTES = 131072;
constexpr int LDSCTL_OFF = RING_BYTES, MISC_OFF = LDSCTL_OFF + 320;
constexpr int LDS_BYTES = 151552;

#define GAS __attribute__((address_space(1)))
#define LAS __attribute__((address_space(3)))
typedef unsigned short bf16;
typedef unsigned v4u __attribute__((ext_vector_type(4)));
typedef unsigned v2u __attribute__((ext_vector_type(2)));
typedef float f32x4 __attribute__((ext_vector_type(4)));
typedef GAS unsigned gu32;
#define RLX_AGENT __ATOMIC_RELAXED, __HIP_MEMORY_SCOPE_AGENT
#define LDS_WAIT() asm volatile("s_waitcnt lgkmcnt(0)" ::: "memory")
#define VM_WAIT() asm volatile("s_waitcnt vmcnt(0)" ::: "memory")
#define LBAR() do { asm volatile("s_waitcnt lgkmcnt(0)" ::: "memory"); __builtin_amdgcn_s_barrier(); asm volatile("" ::: "memory"); } while (0)
typedef float f32x2_t __attribute__((ext_vector_type(2)));
typedef __bf16 bf16x2_t __attribute__((ext_vector_type(2)));
__device__ __forceinline__ unsigned pk2(float lo, float hi) { const f32x2_t v = {lo, hi}; const bf16x2_t b = __builtin_convertvector(v, bf16x2_t); return __builtin_bit_cast(unsigned, b); }
__device__ __forceinline__ unsigned f2bf(float f) { return pk2(f, 0.f) & 0xffffu; }

#define XB_TMO      128
#define XB_XCNT(j)  (256  + 64 * (j))
#define XB_XSUB(j)  (1280 + 64 * (j))
#define XB_XGEN(j)  (2304 + 64 * (j))
#define XB_TOP      3328
#define XB_TOPGEN   3392
#define XCD_BAR_WORDS 3456
#define XB_SPIN_CAP (1u << 22)

__device__ __forceinline__ unsigned xb_ld(unsigned* p)              { return __hip_atomic_load(p, __ATOMIC_RELAXED, __HIP_MEMORY_SCOPE_AGENT); }
__device__ __forceinline__ unsigned xb_add(unsigned* p, unsigned v) { return __hip_atomic_fetch_add(p, v, __ATOMIC_RELAXED, __HIP_MEMORY_SCOPE_AGENT); }
__device__ __forceinline__ unsigned xb_xcc_id() { return (unsigned)__builtin_amdgcn_s_getreg((3 << 11) | 20) & 0xFu; }
#define XB_SPIN(cond, bar) do { unsigned _sp = 0; while (cond) { __builtin_amdgcn_s_sleep(1); \
    if ((++_sp & 255u) == 0u) { if (xb_ld(&(bar)[XB_TMO])) break; if (_sp > XB_SPIN_CAP) { atomicAdd(&(bar)[XB_TMO], 1u); break; } } } } while (0)

struct XcdBarrier { unsigned* bar; unsigned x; volatile LAS unsigned* st; };

__device__ __forceinline__ XcdBarrier xcd_barrier_post(unsigned* bar, volatile LAS unsigned* st) {
    XcdBarrier b; b.bar = bar; b.x = xb_xcc_id(); b.st = st;
    if (threadIdx.x == 0) (void)xb_add(&bar[XB_XCNT(b.x)], 1u);
    return b;
}
__device__ __forceinline__ void xcd_barrier_complete(unsigned* bar, unsigned x, unsigned& nloc, unsigned& nx) {
    const unsigned G = gridDim.x * gridDim.y * gridDim.z;
    unsigned sum, cnt, mine, sp = 0u;
    for (;;) {
        sum = 0u; cnt = 0u; mine = 0u;
#pragma unroll
        for (unsigned j = 0; j < 16; ++j) { const unsigned c = xb_ld(&bar[XB_XCNT(j)]); sum += c; cnt += (c > 0u) ? 1u : 0u; mine = (j == x) ? c : mine; }
        if (sum == G) break;
        __builtin_amdgcn_s_sleep(1);
        if ((++sp & 255u) == 0u) { if (xb_ld(&bar[XB_TMO])) break; if (sp > XB_SPIN_CAP) { atomicAdd(&bar[XB_TMO], 1u); break; } }
    }
    nloc = mine > 0u ? mine : 1u; nx = cnt > 0u ? cnt : 1u;
}
__device__ __forceinline__ void xcd_barrier(const XcdBarrier& b_) {
    asm volatile("s_waitcnt vmcnt(0)" ::: "memory");
    __syncthreads();
    if (threadIdx.x == 0) {
        XcdBarrier b; b.bar = b_.bar; b.st = b_.st; b.x = xb_xcc_id();
        unsigned* bar = b.bar;
        __builtin_amdgcn_s_waitcnt(0);
        unsigned nloc = b.st[0], nx = b.st[1];
        if (nloc == 0u) { xcd_barrier_complete(bar, b.x, nloc, nx); b.st[0] = nloc; b.st[1] = nx; }
        const unsigned old = xb_add(&bar[XB_XSUB(b.x)], 1u);
        const unsigned gen = old / nloc;
        if (old + 1u == (gen + 1u) * nloc) {
            __builtin_amdgcn_fence(__ATOMIC_RELEASE, "agent");
            asm volatile("s_waitcnt vmcnt(0)" ::: "memory");
            const unsigned og = xb_add(&bar[XB_TOP], 1u);
            const unsigned tg = og / nx;
            if (og + 1u == (tg + 1u) * nx) xb_add(&bar[XB_TOPGEN], 1u);
            else XB_SPIN(xb_ld(&bar[XB_TOPGEN]) == tg, bar);
            __builtin_amdgcn_fence(__ATOMIC_ACQUIRE, "agent");
            xb_add(&bar[XB_XGEN(b.x)], 1u);
            asm volatile("s_waitcnt vmcnt(0)" ::: "memory");
        } else {
            XB_SPIN(xb_ld(&bar[XB_XGEN(b.x)]) == gen, bar);
            __builtin_amdgcn_fence(__ATOMIC_ACQUIRE, "agent");
            asm volatile("s_waitcnt vmcnt(0)" ::: "memory");
        }
    }
    __syncthreads();
}

struct Args { const float* in[25]; float* out; unsigned char* ws; };
enum { I_XP = 0, I_XS, I_CP, I_CS, I_ADAW, I_ADAB, I_N1G, I_WIN, I_W0, I_W2, I_A0, I_A2, I_G2, I_KK, I_KA, I_RK, I_LNW, I_LNB, I_POOLW, I_POOLS, I_WOUT, I_N2G, I_MW1, I_MW2, I_FG };

template <int CTRL> __device__ __forceinline__ float dpp_f(float x) {
    return __builtin_bit_cast(float, __builtin_amdgcn_update_dpp(0, __builtin_bit_cast(int, x), CTRL, 0xF, 0xF, true));
}
__device__ __forceinline__ float red8(float x) {
    x += dpp_f<0xB1>(x); x += dpp_f<0x4E>(x); x += dpp_f<0x141>(x); return x;
}
__device__ __forceinline__ float row16_sum(float x) {
    x += dpp_f<0xB1>(x); x += dpp_f<0x4E>(x); x += dpp_f<0x141>(x); x += dpp_f<0x140>(x); return x;
}
__device__ __forceinline__ float wave_sum(float x) {
    x += dpp_f<0xB1>(x); x += dpp_f<0x4E>(x); x += dpp_f<0x141>(x); x += dpp_f<0x140>(x);
    x += __builtin_bit_cast(float, __builtin_amdgcn_update_dpp(0, __builtin_bit_cast(int, x), 0x142, 0xA, 0xF, false));
    x += __builtin_bit_cast(float, __builtin_amdgcn_update_dpp(0, __builtin_bit_cast(int, x), 0x143, 0xC, 0xF, false));
    return __builtin_bit_cast(float, __builtin_amdgcn_readlane(__builtin_bit_cast(int, x), 63));
}
__device__ __forceinline__ f32x4 bf4_f32(v2u w) { f32x4 r; r.x = __builtin_bit_cast(float, w.x << 16); r.y = __builtin_bit_cast(float, w.x & 0xffff0000u); r.z = __builtin_bit_cast(float, w.y << 16); r.w = __builtin_bit_cast(float, w.y & 0xffff0000u); return r; }
__device__ __forceinline__ float bf1_f32(bf16 b) { return __builtin_bit_cast(float, (unsigned)b << 16); }
__device__ __forceinline__ float sigmoidf_(float x) { return __builtin_amdgcn_rcpf(1.f + __expf(-x)); }
__device__ __forceinline__ float tanh_fast(float x) { return 1.f - 2.f * __builtin_amdgcn_rcpf(1.f + __expf(2.f * x)); }
__device__ __forceinline__ float softplus_fast(float z) { return fmaxf(z, 0.f) + __logf(1.f + __expf(-fabsf(z))); }


constexpr int LDB = 72, LDF = 68;
constexpr int SEG_OFF = 131072 + 512;
constexpr int DB_OFF = SEG_OFF + 2304, DBLD = 20;
constexpr int SLOTX_OFF = DB_OFF + 5120;
static_assert(SLOTX_OFF % 16 == 0 && SLOTX_OFF + 9216 <= 151552, "LDS map");
__device__ __forceinline__ void mm_acc(f32x4 (&acc)[2], const LAS bf16* X, const LAS bf16* Y, int it, int jt0, int fr, int fq) {
#pragma unroll
    for (int ks = 0; ks < 2; ++ks) { const pg8::bf16x8 bfrag = *(const LAS pg8::bf16x8*)(X + (16 * it + fr) * LDB + 32 * ks + 8 * fq);
#pragma unroll
        for (int jj = 0; jj < 2; ++jj) { const pg8::bf16x8 afrag = *(const LAS pg8::bf16x8*)(Y + (16 * (jt0 + jj) + fr) * LDB + 32 * ks + 8 * fq);
            acc[jj] = __builtin_amdgcn_mfma_f32_16x16x32_bf16(afrag, bfrag, acc[jj], 0, 0, 0); } }
}
__device__ __forceinline__ void mm_acc4(f32x4 (&acc)[2][2], const LAS bf16* X, const LAS bf16* Y, int i2, int j2, int fr, int fq) {
#pragma unroll
    for (int ks = 0; ks < 2; ++ks) { pg8::bf16x8 bf[2], af[2];
#pragma unroll
        for (int t = 0; t < 2; ++t) { bf[t] = *(const LAS pg8::bf16x8*)(X + (16 * (2 * i2 + t) + fr) * LDB + 32 * ks + 8 * fq); af[t] = *(const LAS pg8::bf16x8*)(Y + (16 * (2 * j2 + t) + fr) * LDB + 32 * ks + 8 * fq); }
#pragma unroll
        for (int ii = 0; ii < 2; ++ii)
#pragma unroll
            for (int jj = 0; jj < 2; ++jj) acc[ii][jj] = __builtin_amdgcn_mfma_f32_16x16x32_bf16(af[jj], bf[ii], acc[ii][jj], 0, 0, 0); }
}
__device__ __forceinline__ pg8::bf16x8 ld_perm(const LAS bf16* M, int row, int c, int fq) {
    const v2u lo = *(const LAS v2u*)(M + row * LDB + 32 * c + 4 * fq), hi = *(const LAS v2u*)(M + row * LDB + 32 * c + 16 + 4 * fq);
    const v4u w = {lo.x, lo.y, hi.x, hi.y}; return __builtin_bit_cast(pg8::bf16x8, w);
}
__device__ __forceinline__ pg8::bf16x8 pack_op(f32x4 a, f32x4 b) { const v4u w = {pk2(a.x, a.y), pk2(a.z, a.w), pk2(b.x, b.y), pk2(b.z, b.w)}; return __builtin_bit_cast(pg8::bf16x8, w); }
__device__ __forceinline__ void st_bf4(LAS bf16* p, f32x4 v) { v2u w; w.x = pk2(v.x, v.y); w.y = pk2(v.z, v.w); *(LAS v2u*)p = w; }
__device__ __forceinline__ void gst_bf4(bf16* p, f32x4 v) { v2u w; w.x = pk2(v.x, v.y); w.y = pk2(v.z, v.w); *(GAS v2u*)p = w; }
__device__ __forceinline__ void p0_transpose_item(const float* W, int K, int N, bf16* WT, int row_off, LAS float* scr, int item, int lane) {
    const int nblk = N / 32, kb = item / nblk, nb = item % nblk, k0 = 64 * kb, n0 = 32 * nb;
    f32x4 tv_[8];
#pragma unroll
    for (int i = 0; i < 8; ++i) { const int kk = 8 * i + (lane >> 3); tv_[i] = *(const f32x4*)(W + (size_t)(k0 + kk) * N + n0 + 4 * (lane & 7)); }
#pragma unroll
    for (int i = 0; i < 8; ++i) { LAS float* d_ = scr + (8 * i + (lane >> 3)) * 33 + 4 * (lane & 7); d_[0] = tv_[i].x; d_[1] = tv_[i].y; d_[2] = tv_[i].z; d_[3] = tv_[i].w; }
    LDS_WAIT(); asm volatile("" ::: "memory");
    const int c = lane & 7;
#pragma unroll
    for (int j = 0; j < 4; ++j) { const int n = (lane >> 3) + 8 * j; const LAS float* s = scr + (8 * c) * 33 + n;
        v4u o; o.x = pk2(s[0 * 33], s[1 * 33]); o.y = pk2(s[2 * 33], s[3 * 33]); o.z = pk2(s[4 * 33], s[5 * 33]); o.w = pk2(s[6 * 33], s[7 * 33]);
        *(GAS v4u*)(WT + (size_t)(row_off + n0 + n) * K + k0 + 8 * c) = o; }
    LDS_WAIT(); asm volatile("" ::: "memory");
}

__global__ void __launch_bounds__(NWAVES * 64, 2) hymba_fwd(Args args) {
    extern __shared__ __attribute__((aligned(16))) unsigned char lds_raw[];
    LAS unsigned char* lds = (LAS unsigned char*)lds_raw;
    volatile LAS unsigned* MISC = (volatile LAS unsigned*)(lds + MISC_OFF);
    const int G = gridDim.x; int bx = blockIdx.x;
    typedef const float* fptr_t;
    const __attribute__((address_space(4))) char* ka = (const __attribute__((address_space(4))) char*)__builtin_amdgcn_kernarg_segment_ptr();
#define RELAUNDER_KA asm volatile("" : "+s"(ka))
#define INP(i) (*(const __attribute__((address_space(4))) fptr_t*)(ka + 8 * (i)))
#define FRESH_IDS int tid = threadIdx.x; asm volatile("" : "+v"(tid)); const int lane = tid & 63, wave = __builtin_amdgcn_readfirstlane(tid >> 6); const int gw = bx * NWAVES + wave, NGW = G * NWAVES; (void)lane; (void)gw; (void)NGW;
    unsigned char* ws = args.ws;
    gu32* ctl = (gu32*)(ws + WS_CTL);
    float* out = args.out;
    float* MOD = (float*)(ws + WS_MOD); float* BON = (float*)(ws + WS_BON);
    bf16* POOLW = (bf16*)(ws + WS_POOLW); bf16* WINT = (bf16*)(ws + WS_WIN); bf16* WOUTT = (bf16*)(ws + WS_WOUT); bf16* W1T = (bf16*)(ws + WS_W1); bf16* W2T = (bf16*)(ws + WS_W2);
    bf16* HB = (bf16*)(ws + WS_H); bf16* MIX = (bf16*)(ws + WS_MIX); bf16* POOLED = (bf16*)(ws + WS_POOLED);
    bf16* PMB = (bf16*)(ws + WS_PM); bf16* QTB = (bf16*)(ws + WS_QT); bf16* RHB = (bf16*)(ws + WS_RH); bf16* W2TB = (bf16*)(ws + WS_W2T); bf16* A2TB = (bf16*)(ws + WS_A2T); bf16* GATE = (bf16*)(ws + WS_GATE); bf16* G2TB = (bf16*)(ws + WS_G2T); bf16* SGX = (bf16*)(ws + WS_SGX); bf16* XR = (bf16*)(ws + WS_XR); bf16* YLT = (bf16*)(ws + WS_YLT);
    bf16* YB = (bf16*)(ws + WS_Y);     bf16* PB = (bf16*)(ws + WS_P);   bf16* F1 = (bf16*)(ws + WS_F1);

    for (int u = threadIdx.x; u < (LDS_BYTES - LDSCTL_OFF) / 4; u += NWAVES * 64) ((LAS unsigned*)(lds + LDSCTL_OFF))[u] = 0u;
    __syncthreads();
    XcdBarrier bar = xcd_barrier_post((unsigned*)(ctl + CW_BAR), MISC + 8);
#define GRID_BAR() xcd_barrier(bar)

    for (int rep0_ = 0; rep0_ < REP_P0; ++rep0_) { if (rep0_) { GRID_BAR(); }
        FRESH_IDS
        LAS float* scr = (LAS float*)(lds + RING_OFF + wave * 16384);
        constexpr int I_IN = (DM / 64) * (INC / 32), I_OUT = (DM / 64) * (DM / 32), I_1 = (DM / 64) * (DFF / 32), I_2 = (DFF / 64) * (DM / 32), I_PL = 4 * (256 / 64) * (256 / 32);
        constexpr int PER_L = I_IN + I_OUT + I_1 + I_2 + I_PL;
        for (int it = gw; it < DEPTH * PER_L; it += NGW) {
            const int l = it / PER_L; int r = it % PER_L;
            if (r < I_IN) { p0_transpose_item(INP(I_WIN) + (size_t)l * DM * INC, DM, INC, WINT + (size_t)l * INCP * DM, 0, scr, r, lane); continue; } r -= I_IN;
            if (r < I_OUT) { p0_transpose_item(INP(I_WOUT) + (size_t)l * DM * DM, DM, DM, WOUTT + (size_t)l * DM * DM, 0, scr, r, lane); continue; } r -= I_OUT;
            if (r < I_1) { p0_transpose_item(INP(I_MW1) + (size_t)l * DM * DFF, DM, DFF, W1T + (size_t)l * DFF * DM, 0, scr, r, lane); continue; } r -= I_1;
            if (r < I_2) { p0_transpose_item(INP(I_MW2) + (size_t)l * DFF * DM, DFF, DM, W2T + (size_t)l * DM * DFF, 0, scr, r, lane); continue; } r -= I_2;
            { const int gi = r / 32, ri = r % 32; p0_transpose_item(INP(I_POOLW) + (size_t)(l * 4 + gi) * 65536, 256, 256, POOLW + (size_t)l * 1024 * 256, gi * 256, scr, ri, lane); }
        }
        for (int i = bx * 512 + tid; i < DEPTH * 24576; i += G * 512) { const int l = i / 24576, r = i % 24576; *((GAS v4u*)(WINT + (size_t)l * INCP * DM + (size_t)INC * DM) + r) = (v4u){0u, 0u, 0u, 0u}; }
        for (int i = bx * 512 + tid; i < 4 * 2 * 16 * 64 * 64; i += G * 512) { const int r = i & 63, nn = (i >> 6) & 63, hh = (i >> 12) & 15, ld = i >> 16;
            W2TB[i] = (bf16)f2bf(INP(I_W2)[((size_t)ld * 64 + r) * 1024 + hh * 64 + nn]); A2TB[i] = (bf16)f2bf(INP(I_A2)[((size_t)ld * 64 + r) * 1024 + hh * 64 + nn]); }
        for (int i = bx * 512 + tid; i < 4 * 1024 * 256; i += G * 512) { const int r = i & 255, cidx = (i >> 8) & 1023, ll = i >> 18;
            G2TB[i] = r < 160 ? (bf16)f2bf(INP(I_G2)[((size_t)ll * 160 + r) * 1024 + cidx]) : (bf16)0; }
        __syncthreads();
        LAS float* sc = (LAS float*)(lds + RING_OFF);
        LAS float* part = (LAS float*)(lds + RING_OFF + 32768);
        if (bx < 192 || G < 192) {
            for (int i = tid; i < 4 * 2048; i += 512) { const int b = i >> 11, k = i & 2047; const float c = (b < 2 ? INP(I_CP) : INP(I_CS))[(b & 1) * 2048 + k]; sc[k * 4 + b] = c / (1.f + __expf(-c)); }
            __syncthreads();
            for (int u = bx; u < 192; u += G) {
                const int l = u / 48, cb = u % 48; const float* Wb = INP(I_ADAW) + (size_t)l * DM * 12288 + cb * 256 + lane * 4;
                f32x4 a0 = {0.f, 0.f, 0.f, 0.f}, a1 = a0, a2 = a0, a3 = a0;
#pragma unroll 8
                for (int kk = 0; kk < 256; ++kk) { const int k = wave * 256 + kk; const f32x4 w = *(const f32x4*)(Wb + (size_t)k * 12288); const f32x4 s = *(const LAS f32x4*)(sc + k * 4);
                    a0 += s.x * w; a1 += s.y * w; a2 += s.z * w; a3 += s.w * w; }
                *(LAS f32x4*)(part + (wave * 4 + 0) * 256 + lane * 4) = a0; *(LAS f32x4*)(part + (wave * 4 + 1) * 256 + lane * 4) = a1;
                *(LAS f32x4*)(part + (wave * 4 + 2) * 256 + lane * 4) = a2; *(LAS f32x4*)(part + (wave * 4 + 3) * 256 + lane * 4) = a3;
                __syncthreads();
                for (int o = tid; o < 1024; o += 512) { const int b = o >> 8, c = o & 255; float s = 0.f;
#pragma unroll
                    for (int w = 0; w < 8; ++w) s += part[(w * 4 + b) * 256 + c];
                    MOD[((size_t)l * 4 + b) * 12288 + cb * 256 + c] = s + INP(I_ADAB)[l * 12288 + cb * 256 + c]; }
                __syncthreads();
            }
        }
    }
    GRID_BAR();

    for (int l_ = 0; l_ < DEPTH; ++l_) {
        int l = l_;
#define RELAUNDER_L do { asm volatile("" : "+s"(l), "+s"(bx)); RELAUNDER_KA; } while (0)
#define modl (MOD + (size_t)l * 4 * 12288)
#define xs0 (l == 0 ? INP(I_XP) : out)
#define xs1 (l == 0 ? INP(I_XS) - (size_t)16384 * DM : out)
        RELAUNDER_L;
#define NORM_PHASE(SRC0, SRC1, GVEC, SHC, SCC) do { FRESH_IDS \
        for (int m = gw; m < NTOK; m += NGW) { const int sq = seq_of_row(m); const float* xr = (m < 16384 ? (SRC0) : (SRC1)) + (size_t)m * DM; \
            const float* shp = modl + sq * 12288 + (SHC) * 2048; const float* scp = modl + sq * 12288 + (SCC) * 2048; \
            f32x4 v[8]; float ss = 0.f; \
            _Pragma("unroll") for (int j = 0; j < 8; ++j) { v[j] = *(const f32x4*)(xr + 4 * lane + 256 * j); ss += (v[j].x * v[j].x + v[j].y * v[j].y) + (v[j].z * v[j].z + v[j].w * v[j].w); } \
            const float rs = 1.0f / sqrtf(wave_sum(ss) * (1.f / DM) + NORM_EPS); \
            _Pragma("unroll") for (int j = 0; j < 8; ++j) { const int c = 4 * lane + 256 * j; const f32x4 gg = *(const f32x4*)((GVEC) + c), sh = *(const f32x4*)(shp + c), sc = *(const f32x4*)(scp + c); \
                const f32x4 o = (v[j] * rs * gg) * (1.f + sc) + sh; v2u w; w.x = pk2(o.x, o.y); w.y = pk2(o.z, o.w); *(GAS v2u*)(HB + (size_t)m * DM + c) = w; } } } while (0)
#define NORM_PHASE_BF(GVEC, SHC, SCC) do { FRESH_IDS        \
        for (int m0_ = gw; m0_ < NTOK; m0_ += 2 * NGW) { const bool two_ = m0_ + NGW < NTOK; const int m1_ = two_ ? m0_ + NGW : m0_; \
            v4u wa_[4], wb_[4]; \
            _Pragma("unroll") for (int j = 0; j < 4; ++j) { wa_[j] = *(const GAS v4u*)(XR + (size_t)m0_ * DM + 8 * lane + 512 * j); wb_[j] = *(const GAS v4u*)(XR + (size_t)m1_ * DM + 8 * lane + 512 * j); } \
            _Pragma("unroll") for (int rr_ = 0; rr_ < 2; ++rr_) { if (rr_ == 1 && !two_) break; const int m = rr_ ? m1_ : m0_; const int sq = seq_of_row(m); \
                const float* shp = modl + sq * 12288 + (SHC) * 2048; const float* scp = modl + sq * 12288 + (SCC) * 2048; \
                f32x4 v[8]; float ss = 0.f; \
                _Pragma("unroll") for (int j = 0; j < 4; ++j) { const v4u w = rr_ ? wb_[j] : wa_[j]; v[2 * j] = bf4_f32((v2u){w.x, w.y}); v[2 * j + 1] = bf4_f32((v2u){w.z, w.w}); } \
                _Pragma("unroll") for (int j = 0; j < 8; ++j) ss += (v[j].x * v[j].x + v[j].y * v[j].y) + (v[j].z * v[j].z + v[j].w * v[j].w); \
                const float rs = 1.0f / sqrtf(wave_sum(ss) * (1.f / DM) + NORM_EPS); \
                _Pragma("unroll") for (int j = 0; j < 4; ++j) { const int c = 8 * lane + 512 * j; v4u w; \
                    { const f32x4 gg = *(const f32x4*)((GVEC) + c), sh = *(const f32x4*)(shp + c), sc = *(const f32x4*)(scp + c); const f32x4 o = (v[2 * j] * rs * gg) * (1.f + sc) + sh; w.x = pk2(o.x, o.y); w.y = pk2(o.z, o.w); } \
                    { const f32x4 gg = *(const f32x4*)((GVEC) + c + 4), sh = *(const f32x4*)(shp + c + 4), sc = *(const f32x4*)(scp + c + 4); const f32x4 o = (v[2 * j + 1] * rs * gg) * (1.f + sc) + sh; w.z = pk2(o.x, o.y); w.w = pk2(o.z, o.w); } \
                    *(GAS v4u*)(HB + (size_t)m * DM + c) = w; } } } } while (0)
        if (l == 0) { NORM_PHASE(INP(I_XP), INP(I_XS) - (size_t)16384 * DM, INP(I_N1G) + l * DM, 0, 1); } else { NORM_PHASE_BF(INP(I_N1G) + l * DM, 0, 1); }
        GRID_BAR(); RELAUNDER_L;

        for (int rep_ = 0; rep_ < REP_P2; ++rep_) { if (rep_) { GRID_BAR(); RELAUNDER_L; } pg8::Gemm g{HB, WINT + (size_t)l * INCP * DM, NTOK, INCP, DM, DM, DM, 0}; pg8::StaticOrder S; S.init(NTOK, INCP, G, bx);
          pg8::EpiBf16<0> E{PB, INCP, nullptr};
          pg8::gemm_phase<pg8::EpiBf16<0>, pg8::StaticOrder, true>(lds + RING_OFF, g, S, E); }
        GRID_BAR(); RELAUNDER_L;

        for (int repn_ = 0; repn_ < REP_MISC; ++repn_) { if (repn_) { GRID_BAR(); RELAUNDER_L; } FRESH_IDS
        for (int i = bx * 512 + tid; i < (NTOK / 32) * 128; i += G * 512) {
            const int run = i >> 7, c8 = (i & 127) * 8, gi = c8 >> 8, hw = 1 << gi, m0 = run * 32;
            const int sq = seq_of_row(m0), sb = seq_base(sq), T = seq_len(sq), t0 = m0 - sb;
            const bf16* ub = PB + (size_t)sb * INCP + C_U + c8;
            f32x4 s0 = {0.f, 0.f, 0.f, 0.f}, s1 = s0;
            { const int lo = t0 - hw < 0 ? 0 : t0 - hw, hi = t0 + hw > T ? T : t0 + hw;
              for (int j = lo; j < hi; ++j) { const v4u x = *(const GAS v4u*)(ub + (size_t)j * INCP); s0 += bf4_f32((v2u){x.x, x.y}); s1 += bf4_f32((v2u){x.z, x.w}); } }
#pragma unroll 4
            for (int tt = 0; tt < 32; ++tt) { const int t = t0 + tt; const int lo = t - hw < 0 ? 0 : t - hw, hi = t + hw > T ? T : t + hw;
                const v4u ux = *(const GAS v4u*)(ub + (size_t)t * INCP);
                const int ta = t + hw < T ? t + hw : T - 1, tb = t - hw >= 0 ? t - hw : 0; const float ma = t + hw < T ? 1.f : 0.f, mb = t - hw >= 0 ? 1.f : 0.f;
                const v4u xa = *(const GAS v4u*)(ub + (size_t)ta * INCP), xb = *(const GAS v4u*)(ub + (size_t)tb * INCP);
                const float inv = 1.f / (float)(hi - lo);
                const f32x4 o0 = s0 * inv - bf4_f32((v2u){ux.x, ux.y}), o1 = s1 * inv - bf4_f32((v2u){ux.z, ux.w}); v4u w; w.x = pk2(o0.x, o0.y); w.y = pk2(o0.z, o0.w); w.z = pk2(o1.x, o1.y); w.w = pk2(o1.z, o1.w);
                *(GAS v4u*)(POOLED + (size_t)(sb + t) * 1024 + c8) = w;
                s0 += ma * bf4_f32((v2u){xa.x, xa.y}) - mb * bf4_f32((v2u){xb.x, xb.y}); s1 += ma * bf4_f32((v2u){xa.z, xa.w}) - mb * bf4_f32((v2u){xb.z, xb.w}); }
        }
        for (int i = bx * 512 + tid; i < NTOK * 64; i += G * 512) { const int m = i >> 6, c = (i & 63) * 4; v2u w = {0u, 0u};
            if (c < 160) { const f32x4 xg = bf4_f32(*(const GAS v2u*)(PB + (size_t)m * INCP + C_XG + c)); w.x = pk2(sigmoidf_(xg.x), sigmoidf_(xg.y)); w.y = pk2(sigmoidf_(xg.z), sigmoidf_(xg.w)); }
            *(GAS v2u*)(SGX + (size_t)m * 256 + c) = w; } }
        { FRESH_IDS
          for (int i = bx * 512 + tid; i < NTOK * 16; i += G * 512) { GAS v4u* q = (GAS v4u*)((bf16*)PB + (size_t)(i >> 4) * INCP + C_XW + (i & 15) * 8); const v4u x = *q;
              const f32x4 a = bf4_f32((v2u){x.x, x.y}), b = bf4_f32((v2u){x.z, x.w}); v4u o;
              o.x = pk2(tanh_fast(a.x), tanh_fast(a.y)); o.y = pk2(tanh_fast(a.z), tanh_fast(a.w)); o.z = pk2(tanh_fast(b.x), tanh_fast(b.y)); o.w = pk2(tanh_fast(b.z), tanh_fast(b.w)); *q = o; } }
        GRID_BAR(); RELAUNDER_L;

        for (int rep12_ = 0; rep12_ < REP_P4BC; ++rep12_) { if (rep12_) { GRID_BAR(); RELAUNDER_L; }
        for (int rep_ = 0; rep_ < REP_P4B; ++rep_) { if (rep_) { GRID_BAR(); RELAUNDER_L; }
        v4u pxw, pxa; v4u pw2, pa2; unsigned rr_raw[8], kr_raw[8], vr_raw[8]; float w0v, a0v, kkc, kac, rkc;
#define P4B_FETCH(uu_) do { const int d_ = (uu_) & 1, h_ = ((uu_) >> 1) & 15, R0_ = ((uu_) >> 5) * 64, ch_ = h_ * 64 + lane; \
            { const int tau_ = tid >> 3, r8_ = (tid & 7) * 8; const bf16* pr_ = PB + (size_t)(d_ ? R0_ + 63 - tau_ : R0_ + tau_) * INCP; \
              pxw = *(const GAS v4u*)(pr_ + C_XW + d_ * 64 + r8_); pxa = *(const GAS v4u*)(pr_ + C_XA + d_ * 64 + r8_); \
              const size_t wo_ = ((size_t)((l * 2 + d_) * 16 + h_) * 64 + tau_) * 64 + r8_; pw2 = *(const GAS v4u*)(W2TB + wo_); pa2 = *(const GAS v4u*)(A2TB + wo_); } \
            _Pragma("unroll") for (int e_ = 0; e_ < 8; ++e_) { const int tau_ = wave * 8 + e_; const bf16* pr_ = PB + (size_t)(d_ ? R0_ + 63 - tau_ : R0_ + tau_) * INCP; rr_raw[e_] = pr_[C_R + ch_]; kr_raw[e_] = pr_[C_K + ch_]; vr_raw[e_] = pr_[C_V + ch_]; } \
            w0v = INP(I_W0)[(l * 2 + d_) * 1024 + ch_]; a0v = INP(I_A0)[(l * 2 + d_) * 1024 + ch_]; kkc = INP(I_KK)[l * 1024 + ch_]; kac = INP(I_KA)[l * 1024 + ch_]; rkc = INP(I_RK)[l * 1024 + ch_]; } while (0)
        { FRESH_IDS P4B_FETCH(bx < 12288 ? bx : 0);
          asm volatile("" : "+v"(pxw), "+v"(pxa), "+v"(pw2), "+v"(pa2));
#pragma unroll
          for (int e = 0; e < 8; ++e) asm volatile("" : "+v"(rr_raw[e]), "+v"(kr_raw[e]), "+v"(vr_raw[e]));
          asm volatile("" : "+v"(w0v), "+v"(a0v), "+v"(kkc), "+v"(kac), "+v"(rkc)); }
        for (int u = bx; u < 12288; u += G) {
            FRESH_IDS
            const int d = u & 1, h = (u >> 1) & 15, cc = u >> 5, R0 = cc * 64;
            const int n = lane, g8 = wave * 8;
            LAS bf16* const SL = (LAS bf16*)(lds + RING_OFF);
#define SLOTP(s) (SL + (s) * (64 * LDB))
            LAS float* const SEG = (LAS float*)(lds + SEG_OFF);
            LAS float* const GC = SEG + 512;
            const int fr = lane & 15, fq = lane >> 4, wg = wave >> 2, i2 = (wave >> 1) & 1, j2 = wave & 1;
#define OI4(ii) (16 * (2 * i2 + (ii)) + fr)
#define OJ4(jj) (16 * (2 * j2 + (jj)) + 4 * fq)
#define FOR_T4 _Pragma("unroll") for (int ii = 0; ii < 2; ++ii) _Pragma("unroll") for (int jj = 0; jj < 2; ++jj)
#define ZERO4 {{{0.f, 0.f, 0.f, 0.f}, {0.f, 0.f, 0.f, 0.f}}, {{0.f, 0.f, 0.f, 0.f}, {0.f, 0.f, 0.f, 0.f}}}
            { const int tau = tid >> 3, r8 = (tid & 7) * 8; const bf16* pr = PB + (size_t)(d ? R0 + 63 - tau : R0 + tau) * INCP;
              *(LAS v4u*)(SLOTP(0) + tau * LDB + r8) = pxw;
              *(LAS v4u*)(SLOTP(1) + tau * LDB + r8) = pxa;
              *(LAS v4u*)(SLOTP(2) + tau * LDB + r8) = pw2;
              *(LAS v4u*)(SLOTP(3) + tau * LDB + r8) = pa2;
            }
            LBAR();
            { f32x4 a_[2][2] = ZERO4; mm_acc4(a_, wg ? SLOTP(1) : SLOTP(0), wg ? SLOTP(3) : SLOTP(2), i2, j2, fr, fq);
              LAS float* Fp = (LAS float*)(wg ? SLOTP(6) : SLOTP(4));
              FOR_T4 *(LAS f32x4*)(Fp + OI4(ii) * LDF + OJ4(jj)) = a_[ii][jj]; }
            LBAR();
            float lw[8], av[8], cl[8];
            { const LAS float* F1p = (const LAS float*)SLOTP(4); const LAS float* F2p = (const LAS float*)SLOTP(6); float run = 0.f;
#pragma unroll
              for (int e = 0; e < 8; ++e) { lw[e] = -0.60653066f * sigmoidf_(w0v + F1p[(g8 + e) * LDF + n]);       av[e] = sigmoidf_(a0v + F2p[(g8 + e) * LDF + n]); run += lw[e]; cl[e] = run; }
              SEG[wave * 64 + n] = run; }
            LBAR();
            for (int rep2_ = 0; rep2_ < REP_S2; ++rep2_) { if (rep2_) LBAR(); float off = 0.f, tot = 0.f;
#pragma unroll
              for (int w = 0; w < 8; ++w) { const float s = SEG[w * 64 + n]; tot += s; if (w < wave) off += s; }
              const float etot = __expf(tot); float pe = __expf(off); if (wave == 0) GC[n] = etot;
              float rr[8], kr[8], vr[8];
#pragma unroll
              for (int e = 0; e < 8; ++e) { unsigned a_ = rr_raw[e], b_ = kr_raw[e], c_ = vr_raw[e]; asm volatile("" : "+v"(a_), "+v"(b_), "+v"(c_)); rr[e] = __builtin_bit_cast(float, a_ << 16); kr[e] = __builtin_bit_cast(float, b_ << 16); vr[e] = __builtin_bit_cast(float, c_ << 16); }
              v4u pa, pb, pk, pv;
              float fta[8], ftb[8], ftk[8]; float bonv = 0.f;
#pragma unroll
              for (int e = 0; e < 8; ++e) { const int tau = g8 + e; const float c = cl[e] + off;
                  const float k1 = kr[e] * kkc; const float ssq = wave_sum(k1 * k1); const float kk = k1 * __builtin_amdgcn_rsqf(fmaxf(ssq, 1e-24f));
                  const float kd = kr[e] * (1.f + (av[e] - 1.f) * kac), bb = kk * av[e];
                  const float bon = wave_sum(rr[e] * kd * rkc);
                  bonv = (lane == e) ? bon : bonv;
                  const float ec = __expf(c), en = __builtin_amdgcn_rcpf(ec), ep = pe, eh = etot * en; pe = ec;
                  const float fa = kk * ep, fb = bb * en, fk = kd * en, fr_ = rr[e] * ec;
                  const unsigned w1_ = pk2(fa, fb), w2_ = pk2(fk, fr_);
                  SLOTP(4)[tau * LDB + n] = (bf16)(w1_ & 0xffffu); SLOTP(5)[tau * LDB + n] = (bf16)(w1_ >> 16); SLOTP(6)[tau * LDB + n] = (bf16)(w2_ & 0xffffu); SLOTP(7)[tau * LDB + n] = (bf16)(w2_ >> 16);
                  fta[e] = fa; ftb[e] = bb * eh; ftk[e] = kd * eh; }
              if (lane < 8) { const int tau = g8 + lane; BON[((size_t)d * NTOK + (d ? R0 + 63 - tau : R0 + tau)) * 16 + h] = bonv; }
              pa.x = pk2(fta[0], fta[1]); pa.y = pk2(fta[2], fta[3]); pa.z = pk2(fta[4], fta[5]); pa.w = pk2(fta[6], fta[7]);
              pb.x = pk2(ftb[0], ftb[1]); pb.y = pk2(ftb[2], ftb[3]); pb.z = pk2(ftb[4], ftb[5]); pb.w = pk2(ftb[6], ftb[7]);
              pk.x = pk2(ftk[0], ftk[1]); pk.y = pk2(ftk[2], ftk[3]); pk.z = pk2(ftk[4], ftk[5]); pk.w = pk2(ftk[6], ftk[7]);
              pv.x = pk2(vr[0], vr[1]); pv.y = pk2(vr[2], vr[3]); pv.z = pk2(vr[4], vr[5]); pv.w = pk2(vr[6], vr[7]);
              *(LAS v4u*)(SLOTP(8) + n * LDB + g8) = pa; *(LAS v4u*)(SLOTP(9) + n * LDB + g8) = pb; *(LAS v4u*)(SLOTP(10) + n * LDB + g8) = pk; *(LAS v4u*)(SLOTP(11) + n * LDB + g8) = pv; }
            { const int un_ = u + G < 12288 ? u + G : u; P4B_FETCH(un_); }
            LBAR();
#define WSYNC() asm volatile("s_waitcnt lgkmcnt(0)" ::: "memory")
            LAS bf16* const SLX = (LAS bf16*)(lds + SLOTX_OFF);
            { const f32x4 zf = {0.f, 0.f, 0.f, 0.f};
#define TILE16(X_, Y_, IT_, JT_, ACC_) do { _Pragma("unroll") for (int ks = 0; ks < 2; ++ks) { \
                    const pg8::bf16x8 bfr_ = *(const LAS pg8::bf16x8*)((X_) + (16 * (IT_) + fr) * LDB + 32 * ks + 8 * fq), afr_ = *(const LAS pg8::bf16x8*)((Y_) + (16 * (JT_) + fr) * LDB + 32 * ks + 8 * fq); \
                    ACC_ = __builtin_amdgcn_mfma_f32_16x16x32_bf16(afr_, bfr_, ACC_, 0, 0, 0); } } while (0)
              if (wave == 0) {
                LAS float* DBp = (LAS float*)(lds + DB_OFF);
#pragma unroll
                for (int b4 = 0; b4 < 4; ++b4) { f32x4 acc = zf; TILE16(SLOTP(4), SLOTP(5), b4, b4, acc);
#pragma unroll
                    for (int q = 0; q < 4; ++q) if (4 * fq + q >= fr) acc[q] = 0.f;
                    *(LAS f32x4*)(DBp + (b4 * 16 + fr) * DBLD + 4 * fq) = acc; }
                { const v4u zz = {0u, 0u, 0u, 0u};
#pragma unroll
                  for (int q = 0; q < 9; ++q) *(LAS v4u*)(SLX + lane * LDB + 8 * q) = zz; }
                const int blk = lane >> 4, cb = lane & 15; const LAS float* Lb = (const LAS float*)(lds + DB_OFF) + blk * 16 * DBLD; float Tc[16];
#define SOLVE_ROWS(I0_, NR_) do { f32x4 Lr[NR_][4]; \
                    _Pragma("unroll") for (int r = 0; r < NR_; ++r) _Pragma("unroll") for (int j4 = 0; j4 < ((I0_) + r + 3) / 4; ++j4) Lr[r][j4] = *(const LAS f32x4*)(Lb + ((I0_) + r) * DBLD + 4 * j4); \
                    WSYNC(); \
                    _Pragma("unroll") for (int r = 0; r < NR_; ++r) { const int i = (I0_) + r; float a0_ = (cb == i) ? 1.f : 0.f, a1_ = 0.f, a2_ = 0.f, a3_ = 0.f; \
                        _Pragma("unroll") for (int j4 = 0; j4 < (i + 3) / 4; ++j4) { const f32x4 Lv = Lr[r][j4]; \
                            if (4 * j4 + 0 < i) a0_ -= Lv.x * Tc[4 * j4 + 0]; if (4 * j4 + 1 < i) a1_ -= Lv.y * Tc[4 * j4 + 1]; if (4 * j4 + 2 < i) a2_ -= Lv.z * Tc[4 * j4 + 2]; if (4 * j4 + 3 < i) a3_ -= Lv.w * Tc[4 * j4 + 3]; } \
                        Tc[i] = (a0_ + a1_) + (a2_ + a3_); \
                        SLX[(16 * blk + i) * LDB + 16 * blk + cb] = (bf16)f2bf(Tc[i]); } } while (0)
                SOLVE_ROWS(0, 8); SOLVE_ROWS(8, 4); SOLVE_ROWS(12, 4);
#undef SOLVE_ROWS
                { v4u w0, w1; w0.x = pk2(Tc[0], Tc[1]); w0.y = pk2(Tc[2], Tc[3]); w0.z = pk2(Tc[4], Tc[5]); w0.w = pk2(Tc[6], Tc[7]); w1.x = pk2(Tc[8], Tc[9]); w1.y = pk2(Tc[10], Tc[11]); w1.z = pk2(Tc[12], Tc[13]); w1.w = pk2(Tc[14], Tc[15]);
                  const v4u zz = {0u, 0u, 0u, 0u};
#pragma unroll
                  for (int b = 0; b < 4; ++b) { *(LAS v4u*)(SLOTP(1) + lane * LDB + 16 * b) = (b == blk) ? w0 : zz; *(LAS v4u*)(SLOTP(1) + lane * LDB + 16 * b + 8) = (b == blk) ? w1 : zz; } }
              } else if (wave == 3) {
#define OFFD(IT_, JT_, DST_) do { f32x4 acc = zf; TILE16(SLOTP(4), SLOTP(5), IT_, JT_, acc); st_bf4((DST_) + (16 * (IT_) + fr) * LDB + 16 * (JT_) + 4 * fq, acc); } while (0)
                OFFD(1, 0, SLOTP(0)); OFFD(3, 2, SLOTP(0)); OFFD(2, 0, SLOTP(13)); OFFD(2, 1, SLOTP(13)); OFFD(3, 0, SLOTP(13)); OFFD(3, 1, SLOTP(13));
#undef OFFD
                st_bf4(SLOTP(0) + (16 + fr) * LDB + 16 + 4 * fq, zf); st_bf4(SLOTP(0) + (48 + fr) * LDB + 48 + 4 * fq, zf);
              } else {
                const bool lo = wave < 4, evn = (wave & 1) == 0; const int hi3 = (wave == 1 || wave == 4 || wave == 5) ? 1 : 0;
                const LAS bf16* Xp = lo ? SLOTP(4) : SLOTP(7); const LAS bf16* Yp = (!lo && evn) ? SLOTP(5) : SLOTP(6);
                LAS bf16* Op = lo ? SLOTP(2) : (evn ? SLOTP(3) : SLOTP(12)); const int mk = lo ? 1 : 0;
#pragma unroll
                for (int rr = 0; rr < 2; ++rr) { const int it = hi3 ? (rr ? 0 : 3) : (rr ? 1 : 2);
                    pg8::bf16x8 bfr[2];
#pragma unroll
                    for (int ks = 0; ks < 2; ++ks) bfr[ks] = *(const LAS pg8::bf16x8*)(Xp + (16 * it + fr) * LDB + 32 * ks + 8 * fq);
#pragma unroll
                    for (int jt = 0; jt < 4; ++jt) { f32x4 acc = zf;
                        if (jt <= it) {
#pragma unroll
                            for (int ks = 0; ks < 2; ++ks) acc = __builtin_amdgcn_mfma_f32_16x16x32_bf16(*(const LAS pg8::bf16x8*)(Yp + (16 * jt + fr) * LDB + 32 * ks + 8 * fq), bfr[ks], acc, 0, 0, 0);
                            if (jt == it) {
#pragma unroll
                                for (int q = 0; q < 4; ++q) if (4 * fq + q + mk > fr) acc[q] = 0.f; } }
                        st_bf4(Op + (16 * it + fr) * LDB + 16 * jt + 4 * fq, acc); } } }
#undef TILE16
            }
            LBAR();
            const int wq = wave & 3; const f32x4 zf4 = {0.f, 0.f, 0.f, 0.f};
            f32x4 pq[4] = {zf4, zf4, zf4, zf4}, py[4] = {zf4, zf4, zf4, zf4};
            pg8::bf16x8 gop[2] = {};
            if (wg == 1) {
                pg8::bf16x8 vb[2];
#pragma unroll
                for (int ks = 0; ks < 2; ++ks) vb[ks] = *(const LAS pg8::bf16x8*)(SLOTP(11) + (16 * wq + fr) * LDB + 32 * ks + 8 * fq);
                f32x4 g_[4] = {zf4, zf4, zf4, zf4};
#pragma unroll
                for (int jt = 0; jt < 4; ++jt)
#pragma unroll
                    for (int ks = 0; ks < 2; ++ks) if (ks == 0 || jt >= 2) g_[jt] = __builtin_amdgcn_mfma_f32_16x16x32_bf16(*(const LAS pg8::bf16x8*)(SLOTP(2) + (16 * jt + fr) * LDB + 32 * ks + 8 * fq), vb[ks], g_[jt], 0, 0, 0);
                gop[0] = pack_op(g_[0], g_[1]); gop[1] = pack_op(g_[2], g_[3]);
#pragma unroll
                for (int jt = 0; jt < 4; ++jt)
#pragma unroll
                    for (int ks = 0; ks < 2; ++ks) pq[jt] = __builtin_amdgcn_mfma_f32_16x16x32_bf16(*(const LAS pg8::bf16x8*)(SLOTP(10) + (16 * jt + fr) * LDB + 32 * ks + 8 * fq), vb[ks], pq[jt], 0, 0, 0);
#pragma unroll
                for (int it = 0; it < 4; ++it)
#pragma unroll
                    for (int ks = 0; ks < 2; ++ks) if (ks == 0 || it >= 2) py[it] = __builtin_amdgcn_mfma_f32_16x16x32_bf16(vb[ks], *(const LAS pg8::bf16x8*)(SLOTP(12) + (16 * it + fr) * LDB + 32 * ks + 8 * fq), py[it], 0, 0, 0);
            } else if (wave == 0) {
                { const v4u zz = {0u, 0u, 0u, 0u};
#pragma unroll
                  for (int q = 0; q < 9; ++q) *(LAS v4u*)(SLOTP(5) + lane * LDB + 8 * q) = zz; }
                WSYNC();
                const f32x4 z4 = {0.f, 0.f, 0.f, 0.f};
#pragma unroll
                for (int p = 0; p < 2; ++p) { const int bj = 2 * p, bk = 2 * p + 1, co = 32 * p + 8 * fq;
                    const pg8::bf16x8 bfr = *(const LAS pg8::bf16x8*)(SLOTP(1) + (16 * bj + fr) * LDB + co), afr = *(const LAS pg8::bf16x8*)(SLOTP(0) + (16 * bk + fr) * LDB + co);
                    st_bf4(SLOTP(5) + (16 * bj + fr) * LDB + 16 * bk + 4 * fq, __builtin_amdgcn_mfma_f32_16x16x32_bf16(afr, bfr, z4, 0, 0, 0)); }
                WSYNC();
#pragma unroll
                for (int p = 0; p < 2; ++p) { const int bi = 2 * p + 1, bj = 2 * p, co = 32 * p + 8 * fq;
                    const pg8::bf16x8 bfr = *(const LAS pg8::bf16x8*)(SLX + (16 * bi + fr) * LDB + co), afr = *(const LAS pg8::bf16x8*)(SLOTP(5) + (16 * bj + fr) * LDB + co);
                    const f32x4 ta = -__builtin_amdgcn_mfma_f32_16x16x32_bf16(afr, bfr, z4, 0, 0, 0); const unsigned p0 = pk2(ta.x, ta.y), p1 = pk2(ta.z, ta.w);
                    const int i_ = 16 * bi + fr, j_ = 16 * bj + 4 * fq;
                    *(LAS v2u*)(SLX + i_ * LDB + j_) = (v2u){p0, p1};
                    SLOTP(1)[(j_ + 0) * LDB + i_] = (bf16)(p0 & 0xffffu); SLOTP(1)[(j_ + 1) * LDB + i_] = (bf16)(p0 >> 16); SLOTP(1)[(j_ + 2) * LDB + i_] = (bf16)(p1 & 0xffffu); SLOTP(1)[(j_ + 3) * LDB + i_] = (bf16)(p1 >> 16); }
                WSYNC();
#pragma unroll
                for (int bj = 0; bj < 2; ++bj)
#pragma unroll
                    for (int bk = 2; bk < 4; ++bk) {
                        const pg8::bf16x8 bfr = *(const LAS pg8::bf16x8*)(SLOTP(1) + (16 * bj + fr) * LDB + 8 * fq), afr = *(const LAS pg8::bf16x8*)(SLOTP(13) + (16 * bk + fr) * LDB + 8 * fq);
                        st_bf4(SLOTP(5) + (16 * bj + fr) * LDB + 16 * bk + 4 * fq, __builtin_amdgcn_mfma_f32_16x16x32_bf16(afr, bfr, z4, 0, 0, 0)); }
                WSYNC();
#pragma unroll
                for (int bi = 2; bi < 4; ++bi)
#pragma unroll
                    for (int bj = 0; bj < 2; ++bj) {
                        const pg8::bf16x8 bfr = *(const LAS pg8::bf16x8*)(SLX + (16 * bi + fr) * LDB + 32 + 8 * fq), afr = *(const LAS pg8::bf16x8*)(SLOTP(5) + (16 * bj + fr) * LDB + 32 + 8 * fq);
                        st_bf4(SLX + (16 * bi + fr) * LDB + 16 * bj + 4 * fq, -__builtin_amdgcn_mfma_f32_16x16x32_bf16(afr, bfr, z4, 0, 0, 0)); }
            }
#undef WSYNC
            LBAR();
            if (wg == 0) {
                pg8::bf16x8 ab[2];
#pragma unroll
                for (int ks = 0; ks < 2; ++ks) ab[ks] = *(const LAS pg8::bf16x8*)(SLOTP(8) + (16 * wq + fr) * LDB + 32 * ks + 8 * fq);
                f32x4 w_[4] = {zf4, zf4, zf4, zf4};
#pragma unroll
                for (int jt = 0; jt < 4; ++jt)
#pragma unroll
                    for (int ks = 0; ks < 2; ++ks) if (ks == 0 || jt >= 2) w_[jt] = __builtin_amdgcn_mfma_f32_16x16x32_bf16(*(const LAS pg8::bf16x8*)(SLX + (16 * jt + fr) * LDB + 32 * ks + 8 * fq), ab[ks], w_[jt], 0, 0, 0);
                pg8::bf16x8 wop[2]; wop[0] = pack_op(w_[0], w_[1]); wop[1] = pack_op(w_[2], w_[3]);
#pragma unroll
                for (int it = 0; it < 4; ++it) { f32x4 ra = zf4, pa = zf4; const int oi = 16 * it + fr, oj = 16 * wq + 4 * fq;
#pragma unroll
                    for (int c = 0; c < 2; ++c) { if (c == 0 || it >= 2) ra = __builtin_amdgcn_mfma_f32_16x16x32_bf16(wop[c], ld_perm(SLOTP(3), oi, c, fq), ra, 0, 0, 0);
                        pa = __builtin_amdgcn_mfma_f32_16x16x32_bf16(wop[c], ld_perm(SLOTP(9), oi, c, fq), pa, 0, 0, 0); }
                    const float gci = GC[oi]; f32x4 pm = -pa;
#pragma unroll
                    for (int q = 0; q < 4; ++q) if (oj + q == oi) pm[q] += gci;
                    st_bf4(SLOTP(10) + oi * LDB + oj, bf4_f32(*(const LAS v2u*)(SLOTP(7) + oi * LDB + oj)) - ra); st_bf4(SLOTP(11) + oi * LDB + oj, pm); }
            } else {
                f32x4 u_[4] = {zf4, zf4, zf4, zf4};
#pragma unroll
                for (int jt = 0; jt < 4; ++jt)
#pragma unroll
                    for (int c = 0; c < 2; ++c) if (c == 0 || jt >= 2) u_[jt] = __builtin_amdgcn_mfma_f32_16x16x32_bf16(ld_perm(SLX, 16 * jt + fr, c, fq), gop[c], u_[jt], 0, 0, 0);
                pg8::bf16x8 uop[2]; uop[0] = pack_op(-u_[0], -u_[1]); uop[1] = pack_op(-u_[2], -u_[3]);
#pragma unroll
                for (int jt = 0; jt < 4; ++jt) {
#pragma unroll
                    for (int c = 0; c < 2; ++c) pq[jt] = __builtin_amdgcn_mfma_f32_16x16x32_bf16(ld_perm(SLOTP(9), 16 * jt + fr, c, fq), uop[c], pq[jt], 0, 0, 0);
                    st_bf4(SLOTP(12) + (16 * wq + fr) * LDB + 16 * jt + 4 * fq, pq[jt]); }
#pragma unroll
                for (int it = 0; it < 4; ++it) {
#pragma unroll
                    for (int c = 0; c < 2; ++c) if (c == 0 || it >= 2) py[it] = __builtin_amdgcn_mfma_f32_16x16x32_bf16(uop[c], ld_perm(SLOTP(3), 16 * it + fr, c, fq), py[it], 0, 0, 0);
                    st_bf4(SLOTP(13) + (16 * it + fr) * LDB + 16 * wq + 4 * fq, py[it]); }
            }
            LBAR();
            asm volatile("" : "+v"(pxw), "+v"(pxa), "+v"(pw2), "+v"(pa2));
#pragma unroll
            for (int e = 0; e < 8; ++e) asm volatile("" : "+v"(rr_raw[e]), "+v"(kr_raw[e]), "+v"(vr_raw[e]));
            asm volatile("" : "+v"(w0v), "+v"(a0v), "+v"(kkc), "+v"(kac), "+v"(rkc));
            { const int row = tid >> 3, ck = tid & 7; const size_t ub = (size_t)u * 4096 + row * 64 + ck * 8;
              *(GAS v4u*)(RHB + ub) = *(const LAS v4u*)(SLOTP(10) + row * LDB + ck * 8); *(GAS v4u*)(PMB + ub) = *(const LAS v4u*)(SLOTP(11) + row * LDB + ck * 8); *(GAS v4u*)(QTB + ub) = *(const LAS v4u*)(SLOTP(12) + row * LDB + ck * 8);
              *(GAS v4u*)(YLT + ub) = *(const LAS v4u*)(SLOTP(13) + row * LDB + ck * 8); }
#undef SLOTP
#undef OI4
#undef OJ4
#undef FOR_T4
#undef ZERO4
        }
#undef P4B_FETCH
        }
        GRID_BAR(); RELAUNDER_L;

        for (int tk = bx; tk < 256; tk += G) {
            FRESH_IDS
            const int wl = wave & 3, vt = wave >> 2, c = lane & 15, g = lane >> 4;
            const int smp = tk >> 7, tq = tk & 127, sp = (tq >> 4) * 8 + (tq & 7), vh = (tq >> 3) & 1, nch = smp ? 64 : 128,     d = (sp >> 4) & 1, h = sp & 15, cbase = seq_base((sp >> 5) + 2 * smp) >> 6;
            const int vcol = 32 * vh + 16 * vt + c;
            LAS bf16* const ZX = (LAS bf16*)(lds + RING_OFF);
            f32x4 Zc = {0.f, 0.f, 0.f, 0.f};
            struct PSet { pg8::bf16x8 O0, O1; v2u Qc; float Yl[4]; };
            PSet s0, s1, s2, s3, s4, s5, s6, s7;
            const bf16* const OWN = vt ? RHB : PMB;
            LAS v4u* const XB = (LAS v4u*)(lds + RING_OFF + 16384);
#define P4C_GEOM(kk_) const int kq_ = (kk_) < nch ? (kk_) : nch - 1; const int cc_ = cbase + (d ? nch - 1 - kq_ : kq_); \
                const size_t ub_ = ((size_t)((cc_ * 16 + h) * 2 + d)) * 4096; const size_t yb_ = ((size_t)d * NTOK + cc_ * 64) * 1024 + h * 64 + 32 * vh + 16 * vt + 4 * g; (void)ub_; (void)yb_;
#define P4C_LOAD(S_, kk_) do { P4C_GEOM(kk_) \
                S_.O0 = *(const pg8::bf16x8*)(OWN + ub_ + (16 * wl + c) * 64 + 8 * g); S_.O1 = *(const pg8::bf16x8*)(OWN + ub_ + (16 * wl + c) * 64 + 32 + 8 * g); \
                S_.Qc = *(const GAS v2u*)(QTB + ub_ + vcol * 64 + 16 * wl + 4 * g); \
                { const f32x4 yl_ = bf4_f32(*(const GAS v2u*)(YLT + ub_ + (16 * wl + c) * 64 + 32 * vh + 16 * vt + 4 * g)); S_.Yl[0] = yl_.x; S_.Yl[1] = yl_.y; S_.Yl[2] = yl_.z; S_.Yl[3] = yl_.w; } } while (0)
#define P4C_STEP(S_, kk_) do { P4C_GEOM(kk_) LAS bf16* zx = ZX + ((kk_) & 1) * (32 * LDB) + (16 * vt + c) * LDB; LAS v4u* xb = XB + ((kk_) & 1) * 1024; \
                st_bf4(zx + 16 * wl + 4 * g, Zc); \
                xb[(wave * 2 + 0) * 64 + lane] = __builtin_bit_cast(v4u, S_.O0); xb[(wave * 2 + 1) * 64 + lane] = __builtin_bit_cast(v4u, S_.O1); \
                LBAR(); \
                { const pg8::bf16x8 Zb0 = *(const LAS pg8::bf16x8*)(zx + 8 * g), Zb1 = *(const LAS pg8::bf16x8*)(zx + 32 + 8 * g); \
                    const pg8::bf16x8 X0 = __builtin_bit_cast(pg8::bf16x8, xb[((wave ^ 4) * 2 + 0) * 64 + lane]), X1 = __builtin_bit_cast(pg8::bf16x8, xb[((wave ^ 4) * 2 + 1) * 64 + lane]); \
                    const pg8::bf16x8 Pa0 = vt ? X0 : S_.O0, Pa1 = vt ? X1 : S_.O1, Ra0 = vt ? S_.O0 : X0, Ra1 = vt ? S_.O1 : X1; \
                    f32x4 ya = {S_.Yl[0], S_.Yl[1], S_.Yl[2], S_.Yl[3]}; \
                    ya = __builtin_amdgcn_mfma_f32_16x16x32_bf16(Zb0, Ra0, ya, 0, 0, 0); ya = __builtin_amdgcn_mfma_f32_16x16x32_bf16(Zb1, Ra1, ya, 0, 0, 0);     \
                    f32x4 za = bf4_f32(S_.Qc); \
                    za = __builtin_amdgcn_mfma_f32_16x16x32_bf16(Pa0, Zb0, za, 0, 0, 0); za = __builtin_amdgcn_mfma_f32_16x16x32_bf16(Pa1, Zb1, za, 0, 0, 0); \
                    Zc = za; \
                    { const int t_ = 16 * wl + c; v2u yw_; yw_.x = pk2(ya[0], ya[1]); yw_.y = pk2(ya[2], ya[3]); *(GAS v2u*)(YB + yb_ + (size_t)(d ? 63 - t_ : t_) * 1024) = yw_; } } } while (0)
            P4C_LOAD(s0, 0); P4C_LOAD(s1, 1); P4C_LOAD(s2, 2); P4C_LOAD(s3, 3); P4C_LOAD(s4, 4); P4C_LOAD(s5, 5); P4C_LOAD(s6, 6); P4C_LOAD(s7, 7);
            for (int k = 0; k < nch; k += 8) {
                P4C_STEP(s0, k);     P4C_LOAD(s0, k + 8);
                P4C_STEP(s1, k + 1); P4C_LOAD(s1, k + 9);
                P4C_STEP(s2, k + 2); P4C_LOAD(s2, k + 10);
                P4C_STEP(s3, k + 3); P4C_LOAD(s3, k + 11);
                P4C_STEP(s4, k + 4); P4C_LOAD(s4, k + 12);
                P4C_STEP(s5, k + 5); P4C_LOAD(s5, k + 13);
                P4C_STEP(s6, k + 6); P4C_LOAD(s6, k + 14);
                P4C_STEP(s7, k + 7); P4C_LOAD(s7, k + 15);
            }
#undef P4C_STEP
#undef P4C_LOAD
#undef P4C_GEOM
            LBAR();
        } }
        __syncthreads(); RELAUNDER_L;
        if (G < 256 || bx >= 128) {
            const int Gs = G >= 256 ? 128 : G, cs = G >= 256 ? bx - 128 : bx;
            pg8::Gemm g{POOLED, POOLW + (size_t)l * 1024 * 256, NTOK, 1024, 256, 1024, 256, 256}; pg8::StaticOrder S; S.init(NTOK, 1024, Gs, cs);
            pg8::EpiBf16<0> E{MIX + 1024, DM, INP(I_POOLS) + l * 1024};
            pg8::gemm_phase<pg8::EpiBf16<0>, pg8::StaticOrder, true>(lds + RING_OFF, g, S, E);
            pg8::Gemm g2_{SGX, G2TB + (size_t)l * 1024 * 256, NTOK, 1024, 256, 256, 256, 0}; pg8::StaticOrder S2_; S2_.init(NTOK, 1024, Gs, cs);
            pg8::EpiBf16<0> E2_{GATE, 1024, nullptr};
            pg8::gemm_phase<pg8::EpiBf16<0>, pg8::StaticOrder, true>(lds + RING_OFF, g2_, S2_, E2_);
        }
        GRID_BAR(); RELAUNDER_L;

        for (int rep_ = 0; rep_ < REP_P6; ++rep_) { if (rep_) { GRID_BAR(); RELAUNDER_L; }
            FRESH_IDS
            const int half = wave & 1, tsel = wave >> 1, chn = 512 * half + 8 * lane, hd = 8 * half + (lane >> 3);
            const f32x4 lw0 = *(const f32x4*)(INP(I_LNW) + l * 1024 + chn), lw1 = *(const f32x4*)(INP(I_LNW) + l * 1024 + chn + 4), lb0 = *(const f32x4*)(INP(I_LNB) + l * 1024 + chn), lb1 = *(const f32x4*)(INP(I_LNB) + l * 1024 + chn + 4);
#pragma unroll 4
            for (int m = bx * 4 + tsel; m < NTOK; m += 4 * G) {
                const v4u ya = *(const GAS v4u*)(YB + (size_t)m * 1024 + chn), yb = *(const GAS v4u*)(YB + ((size_t)NTOK + m) * 1024 + chn);
                const v4u vx = *(const GAS v4u*)(PB + (size_t)m * INCP + C_V + chn), gw = *(const GAS v4u*)(GATE + (size_t)m * 1024 + chn);
                const float bo = BON[(size_t)m * 16 + hd] + BON[((size_t)NTOK + m) * 16 + hd];
                const f32x4 y0 = bf4_f32((v2u){ya.x, ya.y}) + bf4_f32((v2u){yb.x, yb.y}), y1 = bf4_f32((v2u){ya.z, ya.w}) + bf4_f32((v2u){yb.z, yb.w});
                const float mu = red8(((y0.x + y0.y) + (y0.z + y0.w)) + ((y1.x + y1.y) + (y1.z + y1.w))) * (1.f / 64.f); const f32x4 d0 = y0 - mu, d1 = y1 - mu;
                const float var = red8(((d0.x * d0.x + d0.y * d0.y) + (d0.z * d0.z + d0.w * d0.w)) + ((d1.x * d1.x + d1.y * d1.y) + (d1.z * d1.z + d1.w * d1.w))) * (1.f / 64.f); const float rs = __builtin_amdgcn_rsqf(var + GN_EPS);
                const f32x4 o0 = (d0 * rs * lw0 + lb0 + bo * bf4_f32((v2u){vx.x, vx.y})) * bf4_f32((v2u){gw.x, gw.y}), o1 = (d1 * rs * lw1 + lb1 + bo * bf4_f32((v2u){vx.z, vx.w})) * bf4_f32((v2u){gw.z, gw.w});
                v4u w; w.x = pk2(o0.x, o0.y); w.y = pk2(o0.z, o0.w); w.z = pk2(o1.x, o1.y); w.w = pk2(o1.z, o1.w);
                *(GAS v4u*)(MIX + (size_t)m * DM + chn) = w;
            }
        }
        GRID_BAR(); RELAUNDER_L;

        { pg8::Gemm g{MIX, WOUTT + (size_t)l * DM * DM, NTOK, DM, DM, DM, DM, 0}; pg8::StaticOrder S; S.init(NTOK, DM, G, bx);
          pg8::EpiResGate E{l == 0 ? INP(I_XP) : nullptr, l == 0 ? INP(I_XS) - (size_t)16384 * DM : nullptr, XR, modl + 2 * 2048};
          pg8::gemm_phase<pg8::EpiResGate, pg8::StaticOrder, true>(lds + RING_OFF, g, S, E); }
        GRID_BAR(); RELAUNDER_L;

        NORM_PHASE_BF(INP(I_N2G) + l * DM, 3, 4);
        GRID_BAR(); RELAUNDER_L;

        for (int rep_ = 0; rep_ < REP_P9; ++rep_) { if (rep_) { GRID_BAR(); RELAUNDER_L; } pg8::Gemm g{HB, W1T + (size_t)l * DFF * DM, NTOK, DFF, DM, DM, DM, 0}; pg8::StaticOrder S; S.init(NTOK, DFF, G, bx);
          pg8::EpiBf16<1> E{F1, DFF, nullptr};
          pg8::gemm_phase<pg8::EpiBf16<1>, pg8::StaticOrder, true>(lds + RING_OFF, g, S, E); }
        GRID_BAR(); RELAUNDER_L;

        { pg8::Gemm g{F1, W2T + (size_t)l * DM * DFF, NTOK, DM, DFF, DFF, DFF, 0}; pg8::StaticOrder S; S.init(NTOK, DM, G, bx);
          pg8::EpiResGate E{nullptr, nullptr, XR, modl + 5 * 2048};
          pg8::gemm_phase<pg8::EpiResGate, pg8::StaticOrder, true>(lds + RING_OFF, g, S, E); }
        GRID_BAR(); RELAUNDER_L;
    }

    FRESH_IDS
    for (int m = gw; m < NTOK; m += NGW) { const bf16* xr = XR + (size_t)m * DM; float* orow = out + (size_t)m * DM; const float* fg = INP(I_FG);
        f32x4 v[8]; float ss = 0.f;
#pragma unroll
        for (int j = 0; j < 4; ++j) { const v4u w = *(const GAS v4u*)(xr + 8 * lane + 512 * j); v[2 * j] = bf4_f32((v2u){w.x, w.y}); v[2 * j + 1] = bf4_f32((v2u){w.z, w.w}); }
#pragma unroll
        for (int j = 0; j < 8; ++j) ss += (v[j].x * v[j].x + v[j].y * v[j].y) + (v[j].z * v[j].z + v[j].w * v[j].w);
        const float rs = 1.0f / sqrtf(wave_sum(ss) * (1.f / DM) + NORM_EPS);
#pragma unroll
        for (int j = 0; j < 4; ++j) { const int c = 8 * lane + 512 * j; *(f32x4*)(orow + c) = v[2 * j] * rs * *(const f32x4*)(fg + c); *(f32x4*)(orow + c + 4) = v[2 * j + 1] * rs * *(const f32x4*)(fg + c + 4); } }
}

extern "C" void kernel_launch(void* const* d_in, const int* in_sizes, int n_in, void* d_out, int out_size, void* d_ws, size_t ws_size, hipStream_t stream) {
    static int grid = 0;
    if (grid == 0) {
        if (n_in != 25 || out_size != NTOK * DM || ws_size < WS_END) { fprintf(stderr, "kernel_launch: unexpected shapes (n_in %d, out %d, ws %zu); nothing launched\n", n_in, out_size, ws_size); grid = -1; return; }
        int dev = 0, cus = 0, per_cu = 0;
        if (hipGetDevice(&dev) != hipSuccess || hipDeviceGetAttribute(&cus, hipDeviceAttributeMultiprocessorCount, dev) != hipSuccess) { grid = -1; return; }
        if (hipFuncSetAttribute((const void*)hymba_fwd, hipFuncAttributeMaxDynamicSharedMemorySize, LDS_BYTES) != hipSuccess) { fprintf(stderr, "kernel_launch: hipFuncSetAttribute failed\n"); grid = -1; return; }
        if (hipOccupancyMaxActiveBlocksPerMultiprocessor(&per_cu, (const void*)hymba_fwd, NWAVES * 64, LDS_BYTES) != hipSuccess || per_cu < 1) { fprintf(stderr, "kernel_launch: occupancy query reports %d\n", per_cu); }
        (void)hipGetLastError();
        grid = cus;
    }
    if (grid < 0) return;
    if (hipMemsetAsync((char*)d_ws + WS_CTL, 0, CTL_ZERO_BYTES, stream) != hipSuccess) return;
    Args a{};
    for (int i = 0; i < 25; ++i) a.in[i] = (const float*)d_in[i];
    a.out = (float*)d_out; a.ws = (unsigned char*)d_ws;
    hipLaunchKernelGGL(hymba_fwd, dim3(grid), dim3(NWAVES * 64), LDS_BYTES, stream, a);
}
```

```cpp
#include <hip/hip_runtime.h>
#include <cstdio>
#include <cstdint>
#ifndef REP_P2
#define REP_P2 1
#endif
#ifndef REP_P4B
#define REP_P4B 1
#endif
#ifndef REP_S2
#define REP_S2 1
#endif
#ifndef REP_P9
#define REP_P9 1
#endif
#ifndef REP_P4BC
#define REP_P4BC 1
#endif
#ifndef REP_P0
#define REP_P0 1
#endif
#ifndef REP_MISC
#define REP_MISC 1
#endif
#ifndef REP_P6
#define REP_P6 1
#endif

namespace pg8 {
#define PG8_LAS __attribute__((address_space(3)))
typedef unsigned short bf16_t;
typedef short bf16x8 __attribute__((ext_vector_type(8)));
typedef float f32x4 __attribute__((ext_vector_type(4)));
typedef unsigned u32x4 __attribute__((ext_vector_type(4)));
constexpr int BM = 256, BK = 64, HALF = 128, HTB = HALF * BK * 2, STAGE_BYTES = 8 * HTB, NXCD = 8, WGM = 8;

__host__ __device__ __forceinline__ int lds_byte(int r, int c) { const int st = (r >> 4) * 2 + (c >> 5), rr = r & 15, cc = c & 31, ob = rr * 64 + cc * 2; return st * 1024 + (ob ^ (((ob >> 9) & 1) << 5)); }
__host__ __device__ __forceinline__ void stage_rc(int b, int& R, int& C) { const int st = b / 1024, sb = b % 1024, swz = sb ^ (((sb >> 9) & 1) << 5); R = (st >> 1) * 16 + swz / 64; C = (st & 1) * 32 + (swz % 64) / 2; }
__host__ __device__ __forceinline__ int perm32(int rho) { const int n = rho >> 4, i = rho & 15; return 8 * (i >> 2) + 4 * n + (i & 3); }

struct Unit { int pm, pn; };
struct Gemm { const bf16_t* A; const bf16_t* Bt; int M, N, K, lda, ldb, apn; };

struct StaticOrder {
    int nM, nN, nwg, G, c;
    __host__ __device__ void init(int M, int N, int G_, int c_) { nM = M / BM; nN = N / BM; nwg = nM * nN; G = G_; c = c_; }
    __host__ __device__ bool next(int i, Unit& u) const {
        const long L = (long)i * G + c; if (L >= nwg || c < 0) return false;
        int wgid = (int)L; { const int q = nwg / NXCD, r = nwg % NXCD, xcd = wgid % NXCD, off = wgid / NXCD; wgid = (xcd < r ? xcd * (q + 1) : r * (q + 1) + (xcd - r) * q) + off; }
        const int nig = WGM * nN, gid = wgid / nig, fm = gid * WGM, gsz = (nM - fm) < WGM ? (nM - fm) : WGM;
        u.pm = fm + ((wgid % nig) % gsz); u.pn = (wgid % nig) / gsz; return true;
    }
    __device__ __forceinline__ void a_ready(const Unit&) const {}
    __device__ __forceinline__ void done(const Unit&) const {}
};

typedef float f32x2c __attribute__((ext_vector_type(2))); typedef __bf16 bf16x2c __attribute__((ext_vector_type(2)));
__device__ __forceinline__ unsigned cvt_pk_bf16(float lo, float hi) { const f32x2c v = {lo, hi}; const bf16x2c b = __builtin_convertvector(v, bf16x2c); return __builtin_bit_cast(unsigned, b); }

struct EpiF32 {
    static constexpr bool PERM = false;
    float* C; int ldc;
    __device__ __forceinline__ void operator()(const f32x4 (&acc)[2][2][4][2], const Unit& u, int wr, int wc, int fr, int fq) const {
        const int row0 = u.pm * BM + wr * 64 + fr, col0 = u.pn * BM + wc * 32 + 4 * fq;
#pragma unroll
        for (int ai = 0; ai < 2; ++ai)
#pragma unroll
            for (int m = 0; m < 4; ++m) { float* rowp = C + (size_t)(row0 + ai * HALF + m * 16) * ldc + col0;
#pragma unroll
                for (int bj = 0; bj < 2; ++bj)
#pragma unroll
                    for (int n = 0; n < 2; ++n) *(f32x4*)(rowp + bj * HALF + n * 16) = acc[ai][bj][m][n]; }
    }
};
struct EpiResGate {
    static constexpr bool PERM = true;
    const float* srcf0; const float* srcf1; bf16_t* xr; const float* gate;
    __device__ __forceinline__ void operator()(const f32x4 (&acc)[2][2][4][2], const Unit& u, int wr, int wc, int, int) const {
        int ln = threadIdx.x; asm volatile("" : "+v"(ln)); const int fr = ln & 15, fq = (ln & 63) >> 4;
        const int rowt = u.pm * BM; const int sq = rowt < 16384 ? (rowt >> 13) : 2 + ((rowt - 16384) >> 12);
        const float* srcf = rowt < 16384 ? srcf0 : srcf1; const float* gp = gate + sq * 12288;
        const int row0 = rowt + wr * 64 + fr, col0 = u.pn * BM + wc * 32 + 8 * fq;
#pragma unroll
        for (int bj = 0; bj < 2; ++bj) { const f32x4 g0 = *(const f32x4*)(gp + col0 + bj * HALF), g1 = *(const f32x4*)(gp + col0 + bj * HALF + 4);
#pragma unroll
            for (int ai = 0; ai < 2; ++ai)
#pragma unroll
                for (int m = 0; m < 4; ++m) { const size_t off = (size_t)(row0 + ai * HALF + m * 16) * 2048 + col0 + bj * HALF;
                    f32x4 x0, x1;
                    if (srcf0) { x0 = *(const f32x4*)(srcf + off); x1 = *(const f32x4*)(srcf + off + 4); }
                    else { const u32x4 w = *(const u32x4*)(xr + off);
                        x0[0] = __builtin_bit_cast(float, w.x << 16); x0[1] = __builtin_bit_cast(float, w.x & 0xffff0000u); x0[2] = __builtin_bit_cast(float, w.y << 16); x0[3] = __builtin_bit_cast(float, w.y & 0xffff0000u);
                        x1[0] = __builtin_bit_cast(float, w.z << 16); x1[1] = __builtin_bit_cast(float, w.z & 0xffff0000u); x1[2] = __builtin_bit_cast(float, w.w << 16); x1[3] = __builtin_bit_cast(float, w.w & 0xffff0000u); }
                    const f32x4 o0 = x0 + g0 * acc[ai][bj][m][0], o1 = x1 + g1 * acc[ai][bj][m][1];
                    u32x4 ow; ow.x = cvt_pk_bf16(o0[0], o0[1]); ow.y = cvt_pk_bf16(o0[2], o0[3]); ow.z = cvt_pk_bf16(o1[0], o1[1]); ow.w = cvt_pk_bf16(o1[2], o1[3]);
                    *(u32x4*)(xr + off) = ow; } }
    }
};
template <int ACT> struct EpiBf16 {
    static constexpr bool PERM = true;
    bf16_t* O; int ldc; const float* scale;
    __device__ __forceinline__ void operator()(const f32x4 (&acc)[2][2][4][2], const Unit& u, int wr, int wc, int, int) const {
        int ln = threadIdx.x; asm volatile("" : "+v"(ln)); const int fr = ln & 15, fq = (ln & 63) >> 4;
        const int row0 = u.pm * BM + wr * 64 + fr; const int col0 = u.pn * BM + wc * 32 + 8 * fq;
#pragma unroll
        for (int ai = 0; ai < 2; ++ai)
#pragma unroll
            for (int m = 0; m < 4; ++m) { bf16_t* rowp = O + (size_t)(row0 + ai * HALF + m * 16) * ldc + col0;
#pragma unroll
                for (int bj = 0; bj < 2; ++bj) { f32x4 v0 = acc[ai][bj][m][0], v1 = acc[ai][bj][m][1];
                    if (ACT == 1) {
#pragma unroll
                        for (int q = 0; q < 4; ++q) { v0[q] = __builtin_amdgcn_fmed3f(v0[q], 0.f, 3.0e38f); v1[q] = __builtin_amdgcn_fmed3f(v1[q], 0.f, 3.0e38f); }
                        v0 = v0 * v0; v1 = v1 * v1; }
                    if (scale) { v0 = v0 * *(const f32x4*)(scale + col0 + bj * HALF); v1 = v1 * *(const f32x4*)(scale + col0 + bj * HALF + 4); }
                    u32x4 w; w.x = cvt_pk_bf16(v0[0], v0[1]); w.y = cvt_pk_bf16(v0[2], v0[3]); w.z = cvt_pk_bf16(v1[0], v1[1]); w.w = cvt_pk_bf16(v1[2], v1[3]);
                    *(u32x4*)(rowp + bj * HALF) = w; } }
    }
};

template <class Epi, class Sched, bool ALIGN_EPI = false>
__device__ __forceinline__ void gemm_phase(PG8_LAS unsigned char* lds, const Gemm g, const Sched& S, const Epi& E) {
    int tid = threadIdx.x; asm volatile("" : "+v"(tid));
    const int wid = __builtin_amdgcn_readfirstlane(tid >> 6), lane = tid & 63, wr = wid >> 2, wc = wid & 3, fr = lane & 15, fq = lane >> 4;
    const int K = g.K, nt = K / BK;
    unsigned voffA[2], voffB[2];
#pragma unroll
    for (int i = 0; i < 2; ++i) { int R, C; stage_rc(tid * 16 + i * 8192, R, C); const int Rb = Epi::PERM ? ((R & ~31) + perm32(R & 31)) : R;
        voffA[i] = (unsigned)(R * g.lda + C) * 2u; voffB[i] = (unsigned)(Rb * g.ldb + C) * 2u; }
    const size_t kstep = (size_t)(BK * 2);
    const size_t hsA = (size_t)HALF * g.lda * 2, hsB = (size_t)HALF * g.ldb * 2;
    const size_t tsA = 2 * hsA, tsB = 2 * hsB;
    const unsigned ldsw = (unsigned)wid * 1024u;
    const int aoff = lds_byte(wr * 64 + fr, fq * 8), boff = lds_byte(wc * 32 + fr, fq * 8);
#define PG8_SA(b, h) (((b) * 2 + (h)) * HTB)
#define PG8_SB(b, h) ((4 + (b) * 2 + (h)) * HTB)
#define PG8_STAGE(bufoff, gbase, voff) do { _Pragma("unroll") for (int _i = 0; _i < 2; ++_i) \
        __builtin_amdgcn_global_load_lds((const unsigned*)((const char*)(gbase) + (voff)[_i]), (PG8_LAS unsigned*)(lds + (bufoff) + ldsw + _i * 8192), 16, 0, 0); } while (0)
#define PG8_LDA(dst, b, h) do { _Pragma("unroll") for (int m = 0; m < 4; ++m) _Pragma("unroll") for (int k = 0; k < 2; ++k) dst[m][k] = *(const PG8_LAS bf16x8*)(lds + PG8_SA(b, h) + aoff + m * 2048 + k * 1024); } while (0)
#define PG8_LDB(dst, b, h) do { _Pragma("unroll") for (int n = 0; n < 2; ++n) _Pragma("unroll") for (int k = 0; k < 2; ++k) dst[n][k] = *(const PG8_LAS bf16x8*)(lds + PG8_SB(b, h) + boff + n * 2048 + k * 1024); } while (0)
#define PG8_MMA(ai, bj, At, Bt) do { __builtin_amdgcn_s_setprio(1); _Pragma("unroll") for (int m = 0; m < 4; ++m) _Pragma("unroll") for (int n = 0; n < 2; ++n) _Pragma("unroll") for (int k = 0; k < 2; ++k) \
        acc[ai][bj][m][n] = __builtin_amdgcn_mfma_f32_16x16x32_bf16(Bt[n][k], At[m][k], acc[ai][bj][m][n], 0, 0, 0); __builtin_amdgcn_s_setprio(0); } while (0)
#define PG8_WAIT_V(n) asm volatile("s_waitcnt vmcnt(" #n ")" ::: "memory")
#define PG8_WAIT_L(n) asm volatile("s_waitcnt lgkmcnt(" #n ")" ::: "memory")
#define PG8_BAR __builtin_amdgcn_s_barrier()
#define PG8_SCHED __builtin_amdgcn_sched_barrier(0)
    Unit cur, nxt; int ui = 0;
    if (!S.next(0, cur)) return;
    f32x4 acc[2][2][4][2];
#pragma unroll
    for (int a = 0; a < 2; ++a)
#pragma unroll
        for (int b = 0; b < 2; ++b)
#pragma unroll
            for (int m = 0; m < 4; ++m)
#pragma unroll
                for (int n = 0; n < 2; ++n) acc[a][b][m][n] = (f32x4){0.f, 0.f, 0.f, 0.f};
    bf16x8 At[4][2], B0[2][2], B1[2][2];
    const char* cA = (const char*)g.A + (size_t)cur.pm * tsA + (size_t)cur.pn * g.apn * 2; const char* cB = (const char*)g.Bt + (size_t)cur.pn * tsB;
    S.a_ready(cur);
    PG8_STAGE(PG8_SB(0, 0), cB, voffB); PG8_STAGE(PG8_SB(0, 1), cB + hsB, voffB); PG8_STAGE(PG8_SA(0, 0), cA, voffA); PG8_STAGE(PG8_SA(0, 1), cA + hsA, voffA);
    if (wr == 1) PG8_BAR;
    PG8_WAIT_V(2); PG8_BAR;
    PG8_STAGE(PG8_SB(1, 0), cB + kstep, voffB); PG8_STAGE(PG8_SA(1, 0), cA + kstep, voffA); PG8_STAGE(PG8_SB(1, 1), cB + hsB + kstep, voffB);
    PG8_WAIT_V(6); PG8_BAR;
    for (;;) {
        const bool has_next = S.next(ui + 1, nxt);
        const char* nA = has_next ? (const char*)g.A + (size_t)nxt.pm * tsA + (size_t)nxt.pn * g.apn * 2 : cA; const char* nB = has_next ? (const char*)g.Bt + (size_t)nxt.pn * tsB : cB;
        for (int t = 0; t < nt; t += 2) {
            const bool last = (t == nt - 2);
            const char* a1 = cA + (size_t)(t + 1) * kstep;
            const char* a2 = last ? nA : cA + (size_t)(t + 2) * kstep; const char* b2 = last ? nB : cB + (size_t)(t + 2) * kstep;
            const char* a3 = a2 + kstep; const char* b3 = b2 + kstep;
            if (last && has_next) S.a_ready(nxt);
            PG8_LDB(B0, 0, 0); PG8_LDB(B1, 0, 1); PG8_SCHED; PG8_LDA(At, 0, 0); PG8_STAGE(PG8_SA(1, 1), a1 + hsA, voffA);
            PG8_WAIT_V(8); PG8_WAIT_L(0); PG8_BAR; PG8_MMA(0, 0, At, B0); PG8_MMA(0, 1, At, B1); PG8_BAR; PG8_SCHED;
            PG8_LDA(At, 0, 1); PG8_STAGE(PG8_SB(0, 0), b2, voffB); PG8_STAGE(PG8_SB(0, 1), b2 + hsB, voffB); PG8_STAGE(PG8_SA(0, 0), a2, voffA);
            PG8_WAIT_V(8); PG8_WAIT_L(0); PG8_BAR; PG8_MMA(1, 0, At, B0); PG8_MMA(1, 1, At, B1); PG8_BAR; PG8_SCHED;
            PG8_LDB(B0, 1, 0); PG8_LDB(B1, 1, 1); PG8_SCHED; PG8_LDA(At, 1, 0); PG8_STAGE(PG8_SA(0, 1), a2 + hsA, voffA);
            PG8_WAIT_V(8); PG8_WAIT_L(0); PG8_BAR; PG8_MMA(0, 0, At, B0); PG8_MMA(0, 1, At, B1); PG8_BAR; PG8_SCHED;
            PG8_LDA(At, 1, 1); PG8_STAGE(PG8_SB(1, 0), b3, voffB); PG8_STAGE(PG8_SB(1, 1), b3 + hsB, voffB); PG8_STAGE(PG8_SA(1, 0), a3, voffA);
            PG8_WAIT_V(8); PG8_WAIT_L(0); PG8_BAR; PG8_MMA(1, 0, At, B0); PG8_MMA(1, 1, At, B1); PG8_BAR; PG8_SCHED;
        }
        if constexpr (ALIGN_EPI) { if (wr == 0) PG8_BAR; }
        E(acc, cur, wr, wc, fr, fq); S.done(cur);
        if (!has_next) break;
#pragma unroll
        for (int a = 0; a < 2; ++a)
#pragma unroll
            for (int b = 0; b < 2; ++b)
#pragma unroll
                for (int m = 0; m < 4; ++m)
#pragma unroll
                    for (int n = 0; n < 2; ++n) acc[a][b][m][n] = (f32x4){0.f, 0.f, 0.f, 0.f};
        cur = nxt; cA = nA; cB = nB; ++ui;
        if constexpr (ALIGN_EPI) { if (wr == 1) PG8_BAR; }
    }
    PG8_WAIT_V(0);
    if constexpr (!ALIGN_EPI) { if (wr == 0) PG8_BAR; }
    PG8_BAR;
#undef PG8_SA
#undef PG8_SB
#undef PG8_STAGE
#undef PG8_LDA
#undef PG8_LDB
#undef PG8_MMA
#undef PG8_WAIT_V
#undef PG8_WAIT_L
#undef PG8_BAR
#undef PG8_SCHED
}
}

constexpr int NWAVES = 8;
constexpr int DM = 2048, NTOK = 24576, DEPTH = 4, INC = 4512, INCP = 4608, DFF = 8192, RW = 1024, NH = 16, HD = 64;
constexpr int C_R = 0, C_K = 1024, C_V = 2048, C_XW = 3072, C_XA = 3200, C_XG = 3328, C_U = 3488;
constexpr float NORM_EPS = 1e-6f, GN_EPS = 64e-5f;
__device__ __forceinline__ int seq_of_row(int m) { return m < 16384 ? (m >> 13) : 2 + ((m - 16384) >> 12); }
__device__ __forceinline__ int seq_base(int s) { return s < 2 ? s * 8192 : 16384 + (s - 2) * 4096; }
__device__ __forceinline__ int seq_len(int s) { return s < 2 ? 8192 : 4096; }

constexpr size_t MiB = 1u << 20;
constexpr size_t WS_CTL = 0, CTL_ZERO_BYTES = 1 * MiB;
constexpr size_t WS_MOD = 1 * MiB;
constexpr size_t WS_BON = 2 * MiB;
constexpr size_t WS_POOLW = 6 * MiB;
constexpr size_t WS_WIN = 8 * MiB;
constexpr size_t WS_WOUT = 80 * MiB;
constexpr size_t WS_W1 = 112 * MiB;
constexpr size_t WS_W2 = 240 * MiB;
constexpr size_t WS_H = 368 * MiB;
constexpr size_t WS_MIX = 464 * MiB;
constexpr size_t WS_POOLED = 560 * MiB;
constexpr size_t WS_Y = 608 * MiB;
constexpr size_t WS_P = 800 * MiB;
constexpr size_t WS_F1 = 800 * MiB;
constexpr size_t WS_PM = 1196 * MiB;
constexpr size_t WS_QT = 1292 * MiB;
constexpr size_t WS_RH = 368 * MiB;
constexpr size_t WS_W2T = 1388 * MiB, WS_A2T = 1389 * MiB;
constexpr size_t WS_GATE = 1390 * MiB;
constexpr size_t WS_G2T = 1438 * MiB;
constexpr size_t WS_SGX = 1184 * MiB;
constexpr size_t WS_XR = 704 * MiB;
constexpr size_t WS_YLT = 1016 * MiB;
constexpr size_t WS_END = 1440 * MiB;
constexpr int CW_TMO = 0, CW_BAR = 4096;
constexpr size_t WS_SCR = 512 * 1024;

constexpr int RING_OFF = 0, RING_BYTES = 131072;
constexpr int LDSCTL_OFF = RING_BYTES, MISC_OFF = LDSCTL_OFF + 320;
constexpr int LDS_BYTES = 151552;

#define GAS __attribute__((address_space(1)))
#define LAS __attribute__((address_space(3)))
typedef unsigned short bf16;
typedef unsigned v4u __attribute__((ext_vector_type(4)));
typedef unsigned v2u __attribute__((ext_vector_type(2)));
typedef float f32x4 __attribute__((ext_vector_type(4)));
typedef GAS unsigned gu32;
#define RLX_AGENT __ATOMIC_RELAXED, __HIP_MEMORY_SCOPE_AGENT
#define LDS_WAIT() asm volatile("s_waitcnt lgkmcnt(0)" ::: "memory")
#define VM_WAIT() asm volatile("s_waitcnt vmcnt(0)" ::: "memory")
#define LBAR() do { asm volatile("s_waitcnt lgkmcnt(0)" ::: "memory"); __builtin_amdgcn_s_barrier(); asm volatile("" ::: "memory"); } while (0)
typedef float f32x2_t __attribute__((ext_vector_type(2)));
typedef __bf16 bf16x2_t __attribute__((ext_vector_type(2)));
__device__ __forceinline__ unsigned pk2(float lo, float hi) { const f32x2_t v = {lo, hi}; const bf16x2_t b = __builtin_convertvector(v, bf16x2_t); return __builtin_bit_cast(unsigned, b); }
__device__ __forceinline__ unsigned f2bf(float f) { return pk2(f, 0.f) & 0xffffu; }

#define XB_TMO      128
#define XB_XCNT(j)  (256  + 64 * (j))
#define XB_XSUB(j)  (1280 + 64 * (j))
#define XB_XGEN(j)  (2304 + 64 * (j))
#define XB_TOP      3328
#define XB_TOPGEN   3392
#define XCD_BAR_WORDS 3456
#define XB_SPIN_CAP (1u << 22)

__device__ __forceinline__ unsigned xb_ld(unsigned* p)              { return __hip_atomic_load(p, __ATOMIC_RELAXED, __HIP_MEMORY_SCOPE_AGENT); }
__device__ __forceinline__ unsigned xb_add(unsigned* p, unsigned v) { return __hip_atomic_fetch_add(p, v, __ATOMIC_RELAXED, __HIP_MEMORY_SCOPE_AGENT); }
__device__ __forceinline__ unsigned xb_xcc_id() { return (unsigned)__builtin_amdgcn_s_getreg((3 << 11) | 20) & 0xFu; }
#define XB_SPIN(cond, bar) do { unsigned _sp = 0; while (cond) { __builtin_amdgcn_s_sleep(1); \
    if ((++_sp & 255u) == 0u) { if (xb_ld(&(bar)[XB_TMO])) break; if (_sp > XB_SPIN_CAP) { atomicAdd(&(bar)[XB_TMO], 1u); break; } } } } while (0)

struct XcdBarrier { unsigned* bar; unsigned x; volatile LAS unsigned* st; };

__device__ __forceinline__ XcdBarrier xcd_barrier_post(unsigned* bar, volatile LAS unsigned* st) {
    XcdBarrier b; b.bar = bar; b.x = xb_xcc_id(); b.st = st;
    if (threadIdx.x == 0) (void)xb_add(&bar[XB_XCNT(b.x)], 1u);
    return b;
}
__device__ __forceinline__ void xcd_barrier_complete(unsigned* bar, unsigned x, unsigned& nloc, unsigned& nx) {
    const unsigned G = gridDim.x * gridDim.y * gridDim.z;
    unsigned sum, cnt, mine, sp = 0u;
    for (;;) {
        sum = 0u; cnt = 0u; mine = 0u;
#pragma unroll
        for (unsigned j = 0; j < 16; ++j) { const unsigned c = xb_ld(&bar[XB_XCNT(j)]); sum += c; cnt += (c > 0u) ? 1u : 0u; mine = (j == x) ? c : mine; }
        if (sum == G) break;
        __builtin_amdgcn_s_sleep(1);
        if ((++sp & 255u) == 0u) { if (xb_ld(&bar[XB_TMO])) break; if (sp > XB_SPIN_CAP) { atomicAdd(&bar[XB_TMO], 1u); break; } }
    }
    nloc = mine > 0u ? mine : 1u; nx = cnt > 0u ? cnt : 1u;
}
__device__ __forceinline__ void xcd_barrier(const XcdBarrier& b_) {
    asm volatile("s_waitcnt vmcnt(0)" ::: "memory");
    __syncthreads();
    if (threadIdx.x == 0) {
        XcdBarrier b; b.bar = b_.bar; b.st = b_.st; b.x = xb_xcc_id();
        unsigned* bar = b.bar;
        __builtin_amdgcn_s_waitcnt(0);
        unsigned nloc = b.st[0], nx = b.st[1];
        if (nloc == 0u) { xcd_barrier_complete(bar, b.x, nloc, nx); b.st[0] = nloc; b.st[1] = nx; }
        const unsigned old = xb_add(&bar[XB_XSUB(b.x)], 1u);
        const unsigned gen = old / nloc;
        if (old + 1u == (gen + 1u) * nloc) {
            __builtin_amdgcn_fence(__ATOMIC_RELEASE, "agent");
            asm volatile("s_waitcnt vmcnt(0)" ::: "memory");
            const unsigned og = xb_add(&bar[XB_TOP], 1u);
            const unsigned tg = og / nx;
            if (og + 1u == (tg + 1u) * nx) xb_add(&bar[XB_TOPGEN], 1u);
            else XB_SPIN(xb_ld(&bar[XB_TOPGEN]) == tg, bar);
            __builtin_amdgcn_fence(__ATOMIC_ACQUIRE, "agent");
            xb_add(&bar[XB_XGEN(b.x)], 1u);
            asm volatile("s_waitcnt vmcnt(0)" ::: "memory");
        } else {
            XB_SPIN(xb_ld(&bar[XB_XGEN(b.x)]) == gen, bar);
            __builtin_amdgcn_fence(__ATOMIC_ACQUIRE, "agent");
            asm volatile("s_waitcnt vmcnt(0)" ::: "memory");
        }
    }
    __syncthreads();
}

struct Args { const float* in[25]; float* out; unsigned char* ws; };
enum { I_XP = 0, I_XS, I_CP, I_CS, I_ADAW, I_ADAB, I_N1G, I_WIN, I_W0, I_W2, I_A0, I_A2, I_G2, I_KK, I_KA, I_RK, I_LNW, I_LNB, I_POOLW, I_POOLS, I_WOUT, I_N2G, I_MW1, I_MW2, I_FG };

template <int CTRL> __device__ __forceinline__ float dpp_f(float x) {
    return __builtin_bit_cast(float, __builtin_amdgcn_update_dpp(0, __builtin_bit_cast(int, x), CTRL, 0xF, 0xF, true));
}
__device__ __forceinline__ float red8(float x) {
    x += dpp_f<0xB1>(x); x += dpp_f<0x4E>(x); x += dpp_f<0x141>(x); return x;
}
__device__ __forceinline__ float row16_sum(float x) {
    x += dpp_f<0xB1>(x); x += dpp_f<0x4E>(x); x += dpp_f<0x141>(x); x += dpp_f<0x140>(x); return x;
}
__device__ __forceinline__ float wave_sum(float x) {
    x += dpp_f<0xB1>(x); x += dpp_f<0x4E>(x); x += dpp_f<0x141>(x); x += dpp_f<0x140>(x);
    x += __builtin_bit_cast(float, __builtin_amdgcn_update_dpp(0, __builtin_bit_cast(int, x), 0x142, 0xA, 0xF, false));
    x += __builtin_bit_cast(float, __builtin_amdgcn_update_dpp(0, __builtin_bit_cast(int, x), 0x143, 0xC, 0xF, false));
    return __builtin_bit_cast(float, __builtin_amdgcn_readlane(__builtin_bit_cast(int, x), 63));
}
__device__ __forceinline__ f32x4 bf4_f32(v2u w) { f32x4 r; r.x = __builtin_bit_cast(float, w.x << 16); r.y = __builtin_bit_cast(float, w.x & 0xffff0000u); r.z = __builtin_bit_cast(float, w.y << 16); r.w = __builtin_bit_cast(float, w.y & 0xffff0000u); return r; }
__device__ __forceinline__ float bf1_f32(bf16 b) { return __builtin_bit_cast(float, (unsigned)b << 16); }
__device__ __forceinline__ float sigmoidf_(float x) { return __builtin_amdgcn_rcpf(1.f + __expf(-x)); }
__device__ __forceinline__ float tanh_fast(float x) { return 1.f - 2.f * __builtin_amdgcn_rcpf(1.f + __expf(2.f * x)); }
__device__ __forceinline__ float softplus_fast(float z) { return fmaxf(z, 0.f) + __logf(1.f + __expf(-fabsf(z))); }


constexpr int LDB = 72, LDF = 68;
constexpr int SEG_OFF = 131072 + 512;
constexpr int DB_OFF = SEG_OFF + 2304, DBLD = 20;
constexpr int SLOTX_OFF = DB_OFF + 5120;
static_assert(SLOTX_OFF % 16 == 0 && SLOTX_OFF + 9216 <= 151552, "LDS map");
__device__ __forceinline__ void mm_acc(f32x4 (&acc)[2], const LAS bf16* X, const LAS bf16* Y, int it, int jt0, int fr, int fq) {
#pragma unroll
    for (int ks = 0; ks < 2; ++ks) { const pg8::bf16x8 bfrag = *(const LAS pg8::bf16x8*)(X + (16 * it + fr) * LDB + 32 * ks + 8 * fq);
#pragma unroll
        for (int jj = 0; jj < 2; ++jj) { const pg8::bf16x8 afrag = *(const LAS pg8::bf16x8*)(Y + (16 * (jt0 + jj) + fr) * LDB + 32 * ks + 8 * fq);
            acc[jj] = __builtin_amdgcn_mfma_f32_16x16x32_bf16(afrag, bfrag, acc[jj], 0, 0, 0); } }
}
__device__ __forceinline__ void mm_acc4(f32x4 (&acc)[2][2], const LAS bf16* X, const LAS bf16* Y, int i2, int j2, int fr, int fq) {
#pragma unroll
    for (int ks = 0; ks < 2; ++ks) { pg8::bf16x8 bf[2], af[2];
#pragma unroll
        for (int t = 0; t < 2; ++t) { bf[t] = *(const LAS pg8::bf16x8*)(X + (16 * (2 * i2 + t) + fr) * LDB + 32 * ks + 8 * fq); af[t] = *(const LAS pg8::bf16x8*)(Y + (16 * (2 * j2 + t) + fr) * LDB + 32 * ks + 8 * fq); }
#pragma unroll
        for (int ii = 0; ii < 2; ++ii)
#pragma unroll
            for (int jj = 0; jj < 2; ++jj) acc[ii][jj] = __builtin_amdgcn_mfma_f32_16x16x32_bf16(af[jj], bf[ii], acc[ii][jj], 0, 0, 0); }
}
__device__ __forceinline__ pg8::bf16x8 ld_perm(const LAS bf16* M, int row, int c, int fq) {
    const v2u lo = *(const LAS v2u*)(M + row * LDB + 32 * c + 4 * fq), hi = *(const LAS v2u*)(M + row * LDB + 32 * c + 16 + 4 * fq);
    const v4u w = {lo.x, lo.y, hi.x, hi.y}; return __builtin_bit_cast(pg8::bf16x8, w);
}
__device__ __forceinline__ pg8::bf16x8 pack_op(f32x4 a, f32x4 b) { const v4u w = {pk2(a.x, a.y), pk2(a.z, a.w), pk2(b.x, b.y), pk2(b.z, b.w)}; return __builtin_bit_cast(pg8::bf16x8, w); }
__device__ __forceinline__ void st_bf4(LAS bf16* p, f32x4 v) { v2u w; w.x = pk2(v.x, v.y); w.y = pk2(v.z, v.w); *(LAS v2u*)p = w; }
__device__ __forceinline__ void gst_bf4(bf16* p, f32x4 v) { v2u w; w.x = pk2(v.x, v.y); w.y = pk2(v.z, v.w); *(GAS v2u*)p = w; }
__device__ __forceinline__ void p0_transpose_item(const float* W, int K, int N, bf16* WT, int row_off, LAS float* scr, int item, int lane) {
    const int nblk = N / 32, kb = item / nblk, nb = item % nblk, k0 = 64 * kb, n0 = 32 * nb;
    float tv_[32];
#pragma unroll
    for (int i = 0; i < 32; ++i) { const int kk = 2 * i + (lane >> 5); tv_[i] = W[(size_t)(k0 + kk) * N + n0 + (lane & 31)]; }
#pragma unroll
    for (int i = 0; i < 32; ++i) { const int kk = 2 * i + (lane >> 5); scr[kk * 33 + (lane & 31)] = tv_[i]; }
    LDS_WAIT(); asm volatile("" ::: "memory");
    const int c = lane & 7;
#pragma unroll
    for (int j = 0; j < 4; ++j) { const int n = (lane >> 3) + 8 * j; const LAS float* s = scr + (8 * c) * 33 + n;
        v4u o; o.x = pk2(s[0 * 33], s[1 * 33]); o.y = pk2(s[2 * 33], s[3 * 33]); o.z = pk2(s[4 * 33], s[5 * 33]); o.w = pk2(s[6 * 33], s[7 * 33]);
        *(GAS v4u*)(WT + (size_t)(row_off + n0 + n) * K + k0 + 8 * c) = o; }
    LDS_WAIT(); asm volatile("" ::: "memory");
}

__global__ void __launch_bounds__(NWAVES * 64, 2) hymba_fwd(Args args) {
    extern __shared__ __attribute__((aligned(16))) unsigned char lds_raw[];
    LAS unsigned char* lds = (LAS unsigned char*)lds_raw;
    volatile LAS unsigned* MISC = (volatile LAS unsigned*)(lds + MISC_OFF);
    const int G = gridDim.x; int bx = blockIdx.x;
    typedef const float* fptr_t;
    const __attribute__((address_space(4))) char* ka = (const __attribute__((address_space(4))) char*)__builtin_amdgcn_kernarg_segment_ptr();
#define RELAUNDER_KA asm volatile("" : "+s"(ka))
#define INP(i) (*(const __attribute__((address_space(4))) fptr_t*)(ka + 8 * (i)))
#define FRESH_IDS int tid = threadIdx.x; asm volatile("" : "+v"(tid)); const int lane = tid & 63, wave = __builtin_amdgcn_readfirstlane(tid >> 6); const int gw = bx * NWAVES + wave, NGW = G * NWAVES; (void)lane; (void)gw; (void)NGW;
    unsigned char* ws = args.ws;
    gu32* ctl = (gu32*)(ws + WS_CTL);
    float* out = args.out;
    float* MOD = (float*)(ws + WS_MOD); float* BON = (float*)(ws + WS_BON);
    bf16* POOLW = (bf16*)(ws + WS_POOLW); bf16* WINT = (bf16*)(ws + WS_WIN); bf16* WOUTT = (bf16*)(ws + WS_WOUT); bf16* W1T = (bf16*)(ws + WS_W1); bf16* W2T = (bf16*)(ws + WS_W2);
    bf16* HB = (bf16*)(ws + WS_H); bf16* MIX = (bf16*)(ws + WS_MIX); bf16* POOLED = (bf16*)(ws + WS_POOLED);
    bf16* PMB = (bf16*)(ws + WS_PM); bf16* QTB = (bf16*)(ws + WS_QT); bf16* RHB = (bf16*)(ws + WS_RH); bf16* W2TB = (bf16*)(ws + WS_W2T); bf16* A2TB = (bf16*)(ws + WS_A2T); bf16* GATE = (bf16*)(ws + WS_GATE); bf16* G2TB = (bf16*)(ws + WS_G2T); bf16* SGX = (bf16*)(ws + WS_SGX); bf16* XR = (bf16*)(ws + WS_XR); bf16* YLT = (bf16*)(ws + WS_YLT);
    bf16* YB = (bf16*)(ws + WS_Y);     bf16* PB = (bf16*)(ws + WS_P);   bf16* F1 = (bf16*)(ws + WS_F1);

    for (int u = threadIdx.x; u < (LDS_BYTES - LDSCTL_OFF) / 4; u += NWAVES * 64) ((LAS unsigned*)(lds + LDSCTL_OFF))[u] = 0u;
    __syncthreads();
    XcdBarrier bar = xcd_barrier_post((unsigned*)(ctl + CW_BAR), MISC + 8);
#define GRID_BAR() xcd_barrier(bar)

    for (int rep0_ = 0; rep0_ < REP_P0; ++rep0_) { if (rep0_) { GRID_BAR(); }
        FRESH_IDS
        LAS float* scr = (LAS float*)(lds + RING_OFF + wave * 16384);
        constexpr int I_IN = (DM / 64) * (INC / 32), I_OUT = (DM / 64) * (DM / 32), I_1 = (DM / 64) * (DFF / 32), I_2 = (DFF / 64) * (DM / 32), I_PL = 4 * (256 / 64) * (256 / 32);
        constexpr int PER_L = I_IN + I_OUT + I_1 + I_2 + I_PL;
        for (int it = gw; it < DEPTH * PER_L; it += NGW) {
            const int l = it / PER_L; int r = it % PER_L;
            if (r < I_IN) { p0_transpose_item(INP(I_WIN) + (size_t)l * DM * INC, DM, INC, WINT + (size_t)l * INCP * DM, 0, scr, r, lane); continue; } r -= I_IN;
            if (r < I_OUT) { p0_transpose_item(INP(I_WOUT) + (size_t)l * DM * DM, DM, DM, WOUTT + (size_t)l * DM * DM, 0, scr, r, lane); continue; } r -= I_OUT;
            if (r < I_1) { p0_transpose_item(INP(I_MW1) + (size_t)l * DM * DFF, DM, DFF, W1T + (size_t)l * DFF * DM, 0, scr, r, lane); continue; } r -= I_1;
            if (r < I_2) { p0_transpose_item(INP(I_MW2) + (size_t)l * DFF * DM, DFF, DM, W2T + (size_t)l * DM * DFF, 0, scr, r, lane); continue; } r -= I_2;
            { const int gi = r / 32, ri = r % 32; p0_transpose_item(INP(I_POOLW) + (size_t)(l * 4 + gi) * 65536, 256, 256, POOLW + (size_t)l * 1024 * 256, gi * 256, scr, ri, lane); }
        }
        for (int i = bx * 512 + tid; i < DEPTH * 24576; i += G * 512) { const int l = i / 24576, r = i % 24576; *((GAS v4u*)(WINT + (size_t)l * INCP * DM + (size_t)INC * DM) + r) = (v4u){0u, 0u, 0u, 0u}; }
        for (int i = bx * 512 + tid; i < 4 * 2 * 16 * 64 * 64; i += G * 512) { const int r = i & 63, nn = (i >> 6) & 63, hh = (i >> 12) & 15, ld = i >> 16;
            W2TB[i] = (bf16)f2bf(INP(I_W2)[((size_t)ld * 64 + r) * 1024 + hh * 64 + nn]); A2TB[i] = (bf16)f2bf(INP(I_A2)[((size_t)ld * 64 + r) * 1024 + hh * 64 + nn]); }
        for (int i = bx * 512 + tid; i < 4 * 1024 * 256; i += G * 512) { const int r = i & 255, cidx = (i >> 8) & 1023, ll = i >> 18;
            G2TB[i] = r < 160 ? (bf16)f2bf(INP(I_G2)[((size_t)ll * 160 + r) * 1024 + cidx]) : (bf16)0; }
        __syncthreads();
        LAS float* sc = (LAS float*)(lds + RING_OFF);
        LAS float* part = (LAS float*)(lds + RING_OFF + 32768);
        if (bx < 192 || G < 192) {
            for (int i = tid; i < 4 * 2048; i += 512) { const int b = i >> 11, k = i & 2047; const float c = (b < 2 ? INP(I_CP) : INP(I_CS))[(b & 1) * 2048 + k]; sc[k * 4 + b] = c / (1.f + __expf(-c)); }
            __syncthreads();
            for (int u = bx; u < 192; u += G) {
                const int l = u / 48, cb = u % 48; const float* Wb = INP(I_ADAW) + (size_t)l * DM * 12288 + cb * 256 + lane * 4;
                f32x4 a0 = {0.f, 0.f, 0.f, 0.f}, a1 = a0, a2 = a0, a3 = a0;
#pragma unroll 8
                for (int kk = 0; kk < 256; ++kk) { const int k = wave * 256 + kk; const f32x4 w = *(const f32x4*)(Wb + (size_t)k * 12288); const f32x4 s = *(const LAS f32x4*)(sc + k * 4);
                    a0 += s.x * w; a1 += s.y * w; a2 += s.z * w; a3 += s.w * w; }
                *(LAS f32x4*)(part + (wave * 4 + 0) * 256 + lane * 4) = a0; *(LAS f32x4*)(part + (wave * 4 + 1) * 256 + lane * 4) = a1;
                *(LAS f32x4*)(part + (wave * 4 + 2) * 256 + lane * 4) = a2; *(LAS f32x4*)(part + (wave * 4 + 3) * 256 + lane * 4) = a3;
                __syncthreads();
                for (int o = tid; o < 1024; o += 512) { const int b = o >> 8, c = o & 255; float s = 0.f;
#pragma unroll
                    for (int w = 0; w < 8; ++w) s += part[(w * 4 + b) * 256 + c];
                    MOD[((size_t)l * 4 + b) * 12288 + cb * 256 + c] = s + INP(I_ADAB)[l * 12288 + cb * 256 + c]; }
                __syncthreads();
            }
        }
    }
    GRID_BAR();

    for (int l_ = 0; l_ < DEPTH; ++l_) {
        int l = l_;
#define RELAUNDER_L do { asm volatile("" : "+s"(l), "+s"(bx)); RELAUNDER_KA; } while (0)
#define modl (MOD + (size_t)l * 4 * 12288)
#define xs0 (l == 0 ? INP(I_XP) : out)
#define xs1 (l == 0 ? INP(I_XS) - (size_t)16384 * DM : out)
        RELAUNDER_L;
#define NORM_PHASE(SRC0, SRC1, GVEC, SHC, SCC) do { FRESH_IDS \
        for (int m = gw; m < NTOK; m += NGW) { const int sq = seq_of_row(m); const float* xr = (m < 16384 ? (SRC0) : (SRC1)) + (size_t)m * DM; \
            const float* shp = modl + sq * 12288 + (SHC) * 2048; const float* scp = modl + sq * 12288 + (SCC) * 2048; \
            f32x4 v[8]; float ss = 0.f; \
            _Pragma("unroll") for (int j = 0; j < 8; ++j) { v[j] = *(const f32x4*)(xr + 4 * lane + 256 * j); ss += (v[j].x * v[j].x + v[j].y * v[j].y) + (v[j].z * v[j].z + v[j].w * v[j].w); } \
            const float rs = 1.0f / sqrtf(wave_sum(ss) * (1.f / DM) + NORM_EPS); \
            _Pragma("unroll") for (int j = 0; j < 8; ++j) { const int c = 4 * lane + 256 * j; const f32x4 gg = *(const f32x4*)((GVEC) + c), sh = *(const f32x4*)(shp + c), sc = *(const f32x4*)(scp + c); \
                const f32x4 o = (v[j] * rs * gg) * (1.f + sc) + sh; v2u w; w.x = pk2(o.x, o.y); w.y = pk2(o.z, o.w); *(GAS v2u*)(HB + (size_t)m * DM + c) = w; } } } while (0)
#define NORM_PHASE_BF(GVEC, SHC, SCC) do { FRESH_IDS        \
        for (int m0_ = gw; m0_ < NTOK; m0_ += 2 * NGW) { const bool two_ = m0_ + NGW < NTOK; const int m1_ = two_ ? m0_ + NGW : m0_; \
            v4u wa_[4], wb_[4]; \
            _Pragma("unroll") for (int j = 0; j < 4; ++j) { wa_[j] = *(const GAS v4u*)(XR + (size_t)m0_ * DM + 8 * lane + 512 * j); wb_[j] = *(const GAS v4u*)(XR + (size_t)m1_ * DM + 8 * lane + 512 * j); } \
            _Pragma("unroll") for (int rr_ = 0; rr_ < 2; ++rr_) { if (rr_ == 1 && !two_) break; const int m = rr_ ? m1_ : m0_; const int sq = seq_of_row(m); \
                const float* shp = modl + sq * 12288 + (SHC) * 2048; const float* scp = modl + sq * 12288 + (SCC) * 2048; \
                f32x4 v[8]; float ss = 0.f; \
                _Pragma("unroll") for (int j = 0; j < 4; ++j) { const v4u w = rr_ ? wb_[j] : wa_[j]; v[2 * j] = bf4_f32((v2u){w.x, w.y}); v[2 * j + 1] = bf4_f32((v2u){w.z, w.w}); } \
                _Pragma("unroll") for (int j = 0; j < 8; ++j) ss += (v[j].x * v[j].x + v[j].y * v[j].y) + (v[j].z * v[j].z + v[j].w * v[j].w); \
                const float rs = 1.0f / sqrtf(wave_sum(ss) * (1.f / DM) + NORM_EPS); \
                _Pragma("unroll") for (int j = 0; j < 4; ++j) { const int c = 8 * lane + 512 * j; v4u w; \
                    { const f32x4 gg = *(const f32x4*)((GVEC) + c), sh = *(const f32x4*)(shp + c), sc = *(const f32x4*)(scp + c); const f32x4 o = (v[2 * j] * rs * gg) * (1.f + sc) + sh; w.x = pk2(o.x, o.y); w.y = pk2(o.z, o.w); } \
                    { const f32x4 gg = *(const f32x4*)((GVEC) + c + 4), sh = *(const f32x4*)(shp + c + 4), sc = *(const f32x4*)(scp + c + 4); const f32x4 o = (v[2 * j + 1] * rs * gg) * (1.f + sc) + sh; w.z = pk2(o.x, o.y); w.w = pk2(o.z, o.w); } \
                    *(GAS v4u*)(HB + (size_t)m * DM + c) = w; } } } } while (0)
        if (l == 0) { NORM_PHASE(INP(I_XP), INP(I_XS) - (size_t)16384 * DM, INP(I_N1G) + l * DM, 0, 1); } else { NORM_PHASE_BF(INP(I_N1G) + l * DM, 0, 1); }
        GRID_BAR(); RELAUNDER_L;

        for (int rep_ = 0; rep_ < REP_P2; ++rep_) { if (rep_) { GRID_BAR(); RELAUNDER_L; } pg8::Gemm g{HB, WINT + (size_t)l * INCP * DM, NTOK, INCP, DM, DM, DM, 0}; pg8::StaticOrder S; S.init(NTOK, INCP, G, bx);
          pg8::EpiBf16<0> E{PB, INCP, nullptr};
          pg8::gemm_phase<pg8::EpiBf16<0>, pg8::StaticOrder, true>(lds + RING_OFF, g, S, E); }
        GRID_BAR(); RELAUNDER_L;

        for (int repn_ = 0; repn_ < REP_MISC; ++repn_) { if (repn_) { GRID_BAR(); RELAUNDER_L; } FRESH_IDS
        for (int i = bx * 512 + tid; i < (NTOK / 32) * 128; i += G * 512) {
            const int run = i >> 7, c8 = (i & 127) * 8, gi = c8 >> 8, hw = 1 << gi, m0 = run * 32;
            const int sq = seq_of_row(m0), sb = seq_base(sq), T = seq_len(sq), t0 = m0 - sb;
            const bf16* ub = PB + (size_t)sb * INCP + C_U + c8;
            f32x4 s0 = {0.f, 0.f, 0.f, 0.f}, s1 = s0;
            { const int lo = t0 - hw < 0 ? 0 : t0 - hw, hi = t0 + hw > T ? T : t0 + hw;
              for (int j = lo; j < hi; ++j) { const v4u x = *(const GAS v4u*)(ub + (size_t)j * INCP); s0 += bf4_f32((v2u){x.x, x.y}); s1 += bf4_f32((v2u){x.z, x.w}); } }
#pragma unroll 4
            for (int tt = 0; tt < 32; ++tt) { const int t = t0 + tt; const int lo = t - hw < 0 ? 0 : t - hw, hi = t + hw > T ? T : t + hw;
                const v4u ux = *(const GAS v4u*)(ub + (size_t)t * INCP);
                const int ta = t + hw < T ? t + hw : T - 1, tb = t - hw >= 0 ? t - hw : 0; const float ma = t + hw < T ? 1.f : 0.f, mb = t - hw >= 0 ? 1.f : 0.f;
                const v4u xa = *(const GAS v4u*)(ub + (size_t)ta * INCP), xb = *(const GAS v4u*)(ub + (size_t)tb * INCP);
                const float inv = 1.f / (float)(hi - lo);
                const f32x4 o0 = s0 * inv - bf4_f32((v2u){ux.x, ux.y}), o1 = s1 * inv - bf4_f32((v2u){ux.z, ux.w}); v4u w; w.x = pk2(o0.x, o0.y); w.y = pk2(o0.z, o0.w); w.z = pk2(o1.x, o1.y); w.w = pk2(o1.z, o1.w);
                *(GAS v4u*)(POOLED + (size_t)(sb + t) * 1024 + c8) = w;
                s0 += ma * bf4_f32((v2u){xa.x, xa.y}) - mb * bf4_f32((v2u){xb.x, xb.y}); s1 += ma * bf4_f32((v2u){xa.z, xa.w}) - mb * bf4_f32((v2u){xb.z, xb.w}); }
        }
        for (int i = bx * 512 + tid; i < NTOK * 64; i += G * 512) { const int m = i >> 6, c = (i & 63) * 4; v2u w = {0u, 0u};
            if (c < 160) { const f32x4 xg = bf4_f32(*(const GAS v2u*)(PB + (size_t)m * INCP + C_XG + c)); w.x = pk2(sigmoidf_(xg.x), sigmoidf_(xg.y)); w.y = pk2(sigmoidf_(xg.z), sigmoidf_(xg.w)); }
            *(GAS v2u*)(SGX + (size_t)m * 256 + c) = w; } }
        { FRESH_IDS
          for (int i = bx * 512 + tid; i < NTOK * 16; i += G * 512) { GAS v4u* q = (GAS v4u*)((bf16*)PB + (size_t)(i >> 4) * INCP + C_XW + (i & 15) * 8); const v4u x = *q;
              const f32x4 a = bf4_f32((v2u){x.x, x.y}), b = bf4_f32((v2u){x.z, x.w}); v4u o;
              o.x = pk2(tanh_fast(a.x), tanh_fast(a.y)); o.y = pk2(tanh_fast(a.z), tanh_fast(a.w)); o.z = pk2(tanh_fast(b.x), tanh_fast(b.y)); o.w = pk2(tanh_fast(b.z), tanh_fast(b.w)); *q = o; } }
        GRID_BAR(); RELAUNDER_L;

        for (int rep12_ = 0; rep12_ < REP_P4BC; ++rep12_) { if (rep12_) { GRID_BAR(); RELAUNDER_L; }
        for (int rep_ = 0; rep_ < REP_P4B; ++rep_) { if (rep_) { GRID_BAR(); RELAUNDER_L; }
        v4u pxw, pxa; v4u pw2, pa2; v4u prr, prk, prv; float w0v, a0v, kkc, kac, rkc;
#define P4B_FETCH(uu_) do { const int d_ = (uu_) & 1, h_ = ((uu_) >> 1) & 15, R0_ = ((uu_) >> 5) * 64, ch_ = h_ * 64 + lane; \
            { const int tau_ = tid >> 3, r8_ = (tid & 7) * 8; const bf16* pr_ = PB + (size_t)(d_ ? R0_ + 63 - tau_ : R0_ + tau_) * INCP; \
              pxw = *(const GAS v4u*)(pr_ + C_XW + d_ * 64 + r8_); pxa = *(const GAS v4u*)(pr_ + C_XA + d_ * 64 + r8_); \
              prr = *(const GAS v4u*)(pr_ + C_R + h_ * 64 + r8_); prk = *(const GAS v4u*)(pr_ + C_K + h_ * 64 + r8_); prv = *(const GAS v4u*)(pr_ + C_V + h_ * 64 + r8_); \
              const size_t wo_ = ((size_t)((l * 2 + d_) * 16 + h_) * 64 + tau_) * 64 + r8_; pw2 = *(const GAS v4u*)(W2TB + wo_); pa2 = *(const GAS v4u*)(A2TB + wo_); } \
            w0v = INP(I_W0)[(l * 2 + d_) * 1024 + ch_]; a0v = INP(I_A0)[(l * 2 + d_) * 1024 + ch_]; kkc = INP(I_KK)[l * 1024 + ch_]; kac = INP(I_KA)[l * 1024 + ch_]; rkc = INP(I_RK)[l * 1024 + ch_]; } while (0)
        { FRESH_IDS P4B_FETCH(bx < 12288 ? bx : 0);
          asm volatile("" : "+v"(pxw), "+v"(pxa), "+v"(pw2), "+v"(pa2));
asm volatile("" : "+v"(prr), "+v"(prk), "+v"(prv));
          asm volatile("" : "+v"(w0v), "+v"(a0v), "+v"(kkc), "+v"(kac), "+v"(rkc)); }
        for (int u = bx; u < 12288; u += G) {
            FRESH_IDS
            const int d = u & 1, h = (u >> 1) & 15, cc = u >> 5, R0 = cc * 64;
            const int n = lane, g8 = wave * 8;
            LAS bf16* const SL = (LAS bf16*)(lds + RING_OFF);
#define SLOTP(s) (SL + (s) * (64 * LDB))
            LAS float* const SEG = (LAS float*)(lds + SEG_OFF);
            LAS float* const GC = SEG + 512;
            const int fr = lane & 15, fq = lane >> 4, wg = wave >> 2, i2 = (wave >> 1) & 1, j2 = wave & 1;
#define OI4(ii) (16 * (2 * i2 + (ii)) + fr)
#define OJ4(jj) (16 * (2 * j2 + (jj)) + 4 * fq)
#define FOR_T4 _Pragma("unroll") for (int ii = 0; ii < 2; ++ii) _Pragma("unroll") for (int jj = 0; jj < 2; ++jj)
#define ZERO4 {{{0.f, 0.f, 0.f, 0.f}, {0.f, 0.f, 0.f, 0.f}}, {{0.f, 0.f, 0.f, 0.f}, {0.f, 0.f, 0.f, 0.f}}}
            { const int tau = tid >> 3, r8 = (tid & 7) * 8; const bf16* pr = PB + (size_t)(d ? R0 + 63 - tau : R0 + tau) * INCP;
              *(LAS v4u*)(SLOTP(0) + tau * LDB + r8) = pxw;
              *(LAS v4u*)(SLOTP(1) + tau * LDB + r8) = pxa;
              *(LAS v4u*)(SLOTP(2) + tau * LDB + r8) = pw2;
              *(LAS v4u*)(SLOTP(3) + tau * LDB + r8) = pa2;
            }
            LBAR();
            { f32x4 a_[2][2] = ZERO4; mm_acc4(a_, wg ? SLOTP(1) : SLOTP(0), wg ? SLOTP(3) : SLOTP(2), i2, j2, fr, fq);
              LAS float* Fp = (LAS float*)(wg ? SLOTP(6) : SLOTP(4));
              FOR_T4 *(LAS f32x4*)(Fp + OI4(ii) * LDF + OJ4(jj)) = a_[ii][jj]; }
            LBAR();
            float lw[8], av[8], cl[8];
            { const int tau = tid >> 3, r8 = (tid & 7) * 8; *(LAS v4u*)(SLOTP(0) + tau * LDB + r8) = prr; *(LAS v4u*)(SLOTP(1) + tau * LDB + r8) = prk; *(LAS v4u*)(SLOTP(2) + tau * LDB + r8) = prv; }
            { const LAS float* F1p = (const LAS float*)SLOTP(4); const LAS float* F2p = (const LAS float*)SLOTP(6); float run = 0.f;
#pragma unroll
              for (int e = 0; e < 8; ++e) { lw[e] = -0.60653066f * sigmoidf_(w0v + F1p[(g8 + e) * LDF + n]);       av[e] = sigmoidf_(a0v + F2p[(g8 + e) * LDF + n]); run += lw[e]; cl[e] = run; }
              SEG[wave * 64 + n] = run; }
            LBAR();
            for (int rep2_ = 0; rep2_ < REP_S2; ++rep2_) { if (rep2_) LBAR(); float off = 0.f, tot = 0.f;
#pragma unroll
              for (int w = 0; w < 8; ++w) { const float s = SEG[w * 64 + n]; tot += s; if (w < wave) off += s; }
              const float etot = __expf(tot); float pe = __expf(off); if (wave == 0) GC[n] = etot;
              float rr[8], kr[8], vr[8];
#pragma unroll
              for (int e = 0; e < 8; ++e) { rr[e] = __builtin_bit_cast(float, (unsigned)SLOTP(0)[(g8 + e) * LDB + n] << 16); kr[e] = __builtin_bit_cast(float, (unsigned)SLOTP(1)[(g8 + e) * LDB + n] << 16); vr[e] = __builtin_bit_cast(float, (unsigned)SLOTP(2)[(g8 + e) * LDB + n] << 16); }
              v4u pa, pb, pk, pv;
              float fta[8], ftb[8], ftk[8]; float bonv = 0.f;
#pragma unroll
              for (int e = 0; e < 8; ++e) { const int tau = g8 + e; const float c = cl[e] + off;
                  const float k1 = kr[e] * kkc; const float ssq = wave_sum(k1 * k1); const float kk = k1 * __builtin_amdgcn_rsqf(fmaxf(ssq, 1e-24f));
                  const float kd = kr[e] * (1.f + (av[e] - 1.f) * kac), bb = kk * av[e];
                  const float bon = wave_sum(rr[e] * kd * rkc);
                  bonv = (lane == e) ? bon : bonv;
                  const float ec = __expf(c), en = __builtin_amdgcn_rcpf(ec), ep = pe, eh = etot * en; pe = ec;
                  const float fa = kk * ep, fb = bb * en, fk = kd * en, fr_ = rr[e] * ec;
                  const unsigned w1_ = pk2(fa, fb), w2_ = pk2(fk, fr_);
                  SLOTP(4)[tau * LDB + n] = (bf16)(w1_ & 0xffffu); SLOTP(5)[tau * LDB + n] = (bf16)(w1_ >> 16); SLOTP(6)[tau * LDB + n] = (bf16)(w2_ & 0xffffu); SLOTP(7)[tau * LDB + n] = (bf16)(w2_ >> 16);
                  fta[e] = fa; ftb[e] = bb * eh; ftk[e] = kd * eh; }
              if (lane < 8) { const int tau = g8 + lane; BON[((size_t)d * NTOK + (d ? R0 + 63 - tau : R0 + tau)) * 16 + h] = bonv; }
              pa.x = pk2(fta[0], fta[1]); pa.y = pk2(fta[2], fta[3]); pa.z = pk2(fta[4], fta[5]); pa.w = pk2(fta[6], fta[7]);
              pb.x = pk2(ftb[0], ftb[1]); pb.y = pk2(ftb[2], ftb[3]); pb.z = pk2(ftb[4], ftb[5]); pb.w = pk2(ftb[6], ftb[7]);
              pk.x = pk2(ftk[0], ftk[1]); pk.y = pk2(ftk[2], ftk[3]); pk.z = pk2(ftk[4], ftk[5]); pk.w = pk2(ftk[6], ftk[7]);
              pv.x = pk2(vr[0], vr[1]); pv.y = pk2(vr[2], vr[3]); pv.z = pk2(vr[4], vr[5]); pv.w = pk2(vr[6], vr[7]);
              *(LAS v4u*)(SLOTP(8) + n * LDB + g8) = pa; *(LAS v4u*)(SLOTP(9) + n * LDB + g8) = pb; *(LAS v4u*)(SLOTP(10) + n * LDB + g8) = pk; *(LAS v4u*)(SLOTP(11) + n * LDB + g8) = pv; }
            { const int un_ = u + G < 12288 ? u + G : u; P4B_FETCH(un_); }
            LBAR();
#define WSYNC() asm volatile("s_waitcnt lgkmcnt(0)" ::: "memory")
            LAS bf16* const SLX = (LAS bf16*)(lds + SLOTX_OFF);
            { const f32x4 zf = {0.f, 0.f, 0.f, 0.f};
#define TILE16(X_, Y_, IT_, JT_, ACC_) do { _Pragma("unroll") for (int ks = 0; ks < 2; ++ks) { \
                    const pg8::bf16x8 bfr_ = *(const LAS pg8::bf16x8*)((X_) + (16 * (IT_) + fr) * LDB + 32 * ks + 8 * fq), afr_ = *(const LAS pg8::bf16x8*)((Y_) + (16 * (JT_) + fr) * LDB + 32 * ks + 8 * fq); \
                    ACC_ = __builtin_amdgcn_mfma_f32_16x16x32_bf16(afr_, bfr_, ACC_, 0, 0, 0); } } while (0)
              if (wave == 0) {
                LAS float* DBp = (LAS float*)(lds + DB_OFF);
#pragma unroll
                for (int b4 = 0; b4 < 4; ++b4) { f32x4 acc = zf; TILE16(SLOTP(4), SLOTP(5), b4, b4, acc);
#pragma unroll
                    for (int q = 0; q < 4; ++q) if (4 * fq + q >= fr) acc[q] = 0.f;
                    *(LAS f32x4*)(DBp + (b4 * 16 + fr) * DBLD + 4 * fq) = acc; }
                { const v4u zz = {0u, 0u, 0u, 0u};
#pragma unroll
                  for (int q = 0; q < 9; ++q) *(LAS v4u*)(SLX + lane * LDB + 8 * q) = zz; }
                const int blk = lane >> 4, cb = lane & 15; const LAS float* Lb = (const LAS float*)(lds + DB_OFF) + blk * 16 * DBLD; float Tc[16];
#define SOLVE_ROWS(I0_, NR_) do { f32x4 Lr[NR_][4]; \
                    _Pragma("unroll") for (int r = 0; r < NR_; ++r) _Pragma("unroll") for (int j4 = 0; j4 < ((I0_) + r + 3) / 4; ++j4) Lr[r][j4] = *(const LAS f32x4*)(Lb + ((I0_) + r) * DBLD + 4 * j4); \
                    WSYNC(); \
                    _Pragma("unroll") for (int r = 0; r < NR_; ++r) { const int i = (I0_) + r; float a0_ = (cb == i) ? 1.f : 0.f, a1_ = 0.f, a2_ = 0.f, a3_ = 0.f; \
                        _Pragma("unroll") for (int j4 = 0; j4 < (i + 3) / 4; ++j4) { const f32x4 Lv = Lr[r][j4]; \
                            if (4 * j4 + 0 < i) a0_ -= Lv.x * Tc[4 * j4 + 0]; if (4 * j4 + 1 < i) a1_ -= Lv.y * Tc[4 * j4 + 1]; if (4 * j4 + 2 < i) a2_ -= Lv.z * Tc[4 * j4 + 2]; if (4 * j4 + 3 < i) a3_ -= Lv.w * Tc[4 * j4 + 3]; } \
                        Tc[i] = (a0_ + a1_) + (a2_ + a3_); \
                        SLX[(16 * blk + i) * LDB + 16 * blk + cb] = (bf16)f2bf(Tc[i]); } } while (0)
                SOLVE_ROWS(0, 8); SOLVE_ROWS(8, 4); SOLVE_ROWS(12, 4);
#undef SOLVE_ROWS
                { v4u w0, w1; w0.x = pk2(Tc[0], Tc[1]); w0.y = pk2(Tc[2], Tc[3]); w0.z = pk2(Tc[4], Tc[5]); w0.w = pk2(Tc[6], Tc[7]); w1.x = pk2(Tc[8], Tc[9]); w1.y = pk2(Tc[10], Tc[11]); w1.z = pk2(Tc[12], Tc[13]); w1.w = pk2(Tc[14], Tc[15]);
                  const v4u zz = {0u, 0u, 0u, 0u};
#pragma unroll
                  for (int b = 0; b < 4; ++b) { *(LAS v4u*)(SLOTP(1) + lane * LDB + 16 * b) = (b == blk) ? w0 : zz; *(LAS v4u*)(SLOTP(1) + lane * LDB + 16 * b + 8) = (b == blk) ? w1 : zz; } }
              } else if (wave == 3) {
#define OFFD(IT_, JT_, DST_) do { f32x4 acc = zf; TILE16(SLOTP(4), SLOTP(5), IT_, JT_, acc); st_bf4((DST_) + (16 * (IT_) + fr) * LDB + 16 * (JT_) + 4 * fq, acc); } while (0)
                OFFD(1, 0, SLOTP(0)); OFFD(3, 2, SLOTP(0)); OFFD(2, 0, SLOTP(13)); OFFD(2, 1, SLOTP(13)); OFFD(3, 0, SLOTP(13)); OFFD(3, 1, SLOTP(13));
#undef OFFD
                st_bf4(SLOTP(0) + (16 + fr) * LDB + 16 + 4 * fq, zf); st_bf4(SLOTP(0) + (48 + fr) * LDB + 48 + 4 * fq, zf);
              } else {
                const bool lo = wave < 4, evn = (wave & 1) == 0; const int hi3 = (wave == 1 || wave == 4 || wave == 5) ? 1 : 0;
                const LAS bf16* Xp = lo ? SLOTP(4) : SLOTP(7); const LAS bf16* Yp = (!lo && evn) ? SLOTP(5) : SLOTP(6);
                LAS bf16* Op = lo ? SLOTP(2) : (evn ? SLOTP(3) : SLOTP(12)); const int mk = lo ? 1 : 0;
#pragma unroll
                for (int rr = 0; rr < 2; ++rr) { const int it = hi3 ? (rr ? 0 : 3) : (rr ? 1 : 2);
                    pg8::bf16x8 bfr[2];
#pragma unroll
                    for (int ks = 0; ks < 2; ++ks) bfr[ks] = *(const LAS pg8::bf16x8*)(Xp + (16 * it + fr) * LDB + 32 * ks + 8 * fq);
#pragma unroll
                    for (int jt = 0; jt < 4; ++jt) { f32x4 acc = zf;
                        if (jt <= it) {
#pragma unroll
                            for (int ks = 0; ks < 2; ++ks) acc = __builtin_amdgcn_mfma_f32_16x16x32_bf16(*(const LAS pg8::bf16x8*)(Yp + (16 * jt + fr) * LDB + 32 * ks + 8 * fq), bfr[ks], acc, 0, 0, 0);
                            if (jt == it) {
#pragma unroll
                                for (int q = 0; q < 4; ++q) if (4 * fq + q + mk > fr) acc[q] = 0.f; } }
                        st_bf4(Op + (16 * it + fr) * LDB + 16 * jt + 4 * fq, acc); } } }
#undef TILE16
            }
            LBAR();
            const int wq = wave & 3; const f32x4 zf4 = {0.f, 0.f, 0.f, 0.f};
            f32x4 pq[4] = {zf4, zf4, zf4, zf4}, py[4] = {zf4, zf4, zf4, zf4};
            pg8::bf16x8 gop[2] = {};
            if (wg == 1) {
                pg8::bf16x8 vb[2];
#pragma unroll
                for (int ks = 0; ks < 2; ++ks) vb[ks] = *(const LAS pg8::bf16x8*)(SLOTP(11) + (16 * wq + fr) * LDB + 32 * ks + 8 * fq);
                f32x4 g_[4] = {zf4, zf4, zf4, zf4};
#pragma unroll
                for (int jt = 0; jt < 4; ++jt)
#pragma unroll
                    for (int ks = 0; ks < 2; ++ks) if (ks == 0 || jt >= 2) g_[jt] = __builtin_amdgcn_mfma_f32_16x16x32_bf16(*(const LAS pg8::bf16x8*)(SLOTP(2) + (16 * jt + fr) * LDB + 32 * ks + 8 * fq), vb[ks], g_[jt], 0, 0, 0);
                gop[0] = pack_op(g_[0], g_[1]); gop[1] = pack_op(g_[2], g_[3]);
#pragma unroll
                for (int jt = 0; jt < 4; ++jt)
#pragma unroll
                    for (int ks = 0; ks < 2; ++ks) pq[jt] = __builtin_amdgcn_mfma_f32_16x16x32_bf16(*(const LAS pg8::bf16x8*)(SLOTP(10) + (16 * jt + fr) * LDB + 32 * ks + 8 * fq), vb[ks], pq[jt], 0, 0, 0);
#pragma unroll
                for (int it = 0; it < 4; ++it)
#pragma unroll
                    for (int ks = 0; ks < 2; ++ks) if (ks == 0 || it >= 2) py[it] = __builtin_amdgcn_mfma_f32_16x16x32_bf16(vb[ks], *(const LAS pg8::bf16x8*)(SLOTP(12) + (16 * it + fr) * LDB + 32 * ks + 8 * fq), py[it], 0, 0, 0);
            } else if (wave == 0) {
                { const v4u zz = {0u, 0u, 0u, 0u};
#pragma unroll
                  for (int q = 0; q < 9; ++q) *(LAS v4u*)(SLOTP(5) + lane * LDB + 8 * q) = zz; }
                WSYNC();
                const f32x4 z4 = {0.f, 0.f, 0.f, 0.f};
#pragma unroll
                for (int p = 0; p < 2; ++p) { const int bj = 2 * p, bk = 2 * p + 1, co = 32 * p + 8 * fq;
                    const pg8::bf16x8 bfr = *(const LAS pg8::bf16x8*)(SLOTP(1) + (16 * bj + fr) * LDB + co), afr = *(const LAS pg8::bf16x8*)(SLOTP(0) + (16 * bk + fr) * LDB + co);
                    st_bf4(SLOTP(5) + (16 * bj + fr) * LDB + 16 * bk + 4 * fq, __builtin_amdgcn_mfma_f32_16x16x32_bf16(afr, bfr, z4, 0, 0, 0)); }
                WSYNC();
#pragma unroll
                for (int p = 0; p < 2; ++p) { const int bi = 2 * p + 1, bj = 2 * p, co = 32 * p + 8 * fq;
                    const pg8::bf16x8 bfr = *(const LAS pg8::bf16x8*)(SLX + (16 * bi + fr) * LDB + co), afr = *(const LAS pg8::bf16x8*)(SLOTP(5) + (16 * bj + fr) * LDB + co);
                    const f32x4 ta = -__builtin_amdgcn_mfma_f32_16x16x32_bf16(afr, bfr, z4, 0, 0, 0); const unsigned p0 = pk2(ta.x, ta.y), p1 = pk2(ta.z, ta.w);
                    const int i_ = 16 * bi + fr, j_ = 16 * bj + 4 * fq;
                    *(LAS v2u*)(SLX + i_ * LDB + j_) = (v2u){p0, p1};
                    SLOTP(1)[(j_ + 0) * LDB + i_] = (bf16)(p0 & 0xffffu); SLOTP(1)[(j_ + 1) * LDB + i_] = (bf16)(p0 >> 16); SLOTP(1)[(j_ + 2) * LDB + i_] = (bf16)(p1 & 0xffffu); SLOTP(1)[(j_ + 3) * LDB + i_] = (bf16)(p1 >> 16); }
                WSYNC();
#pragma unroll
                for (int bj = 0; bj < 2; ++bj)
#pragma unroll
                    for (int bk = 2; bk < 4; ++bk) {
                        const pg8::bf16x8 bfr = *(const LAS pg8::bf16x8*)(SLOTP(1) + (16 * bj + fr) * LDB + 8 * fq), afr = *(const LAS pg8::bf16x8*)(SLOTP(13) + (16 * bk + fr) * LDB + 8 * fq);
                        st_bf4(SLOTP(5) + (16 * bj + fr) * LDB + 16 * bk + 4 * fq, __builtin_amdgcn_mfma_f32_16x16x32_bf16(afr, bfr, z4, 0, 0, 0)); }
                WSYNC();
#pragma unroll
                for (int bi = 2; bi < 4; ++bi)
#pragma unroll
                    for (int bj = 0; bj < 2; ++bj) {
                        const pg8::bf16x8 bfr = *(const LAS pg8::bf16x8*)(SLX + (16 * bi + fr) * LDB + 32 + 8 * fq), afr = *(const LAS pg8::bf16x8*)(SLOTP(5) + (16 * bj + fr) * LDB + 32 + 8 * fq);
                        st_bf4(SLX + (16 * bi + fr) * LDB + 16 * bj + 4 * fq, -__builtin_amdgcn_mfma_f32_16x16x32_bf16(afr, bfr, z4, 0, 0, 0)); }
            }
#undef WSYNC
            LBAR();
            if (wg == 0) {
                pg8::bf16x8 ab[2];
#pragma unroll
                for (int ks = 0; ks < 2; ++ks) ab[ks] = *(const LAS pg8::bf16x8*)(SLOTP(8) + (16 * wq + fr) * LDB + 32 * ks + 8 * fq);
                f32x4 w_[4] = {zf4, zf4, zf4, zf4};
#pragma unroll
                for (int jt = 0; jt < 4; ++jt)
#pragma unroll
                    for (int ks = 0; ks < 2; ++ks) if (ks == 0 || jt >= 2) w_[jt] = __builtin_amdgcn_mfma_f32_16x16x32_bf16(*(const LAS pg8::bf16x8*)(SLX + (16 * jt + fr) * LDB + 32 * ks + 8 * fq), ab[ks], w_[jt], 0, 0, 0);
                pg8::bf16x8 wop[2]; wop[0] = pack_op(w_[0], w_[1]); wop[1] = pack_op(w_[2], w_[3]);
#pragma unroll
                for (int it = 0; it < 4; ++it) { f32x4 ra = zf4, pa = zf4; const int oi = 16 * it + fr, oj = 16 * wq + 4 * fq;
#pragma unroll
                    for (int c = 0; c < 2; ++c) { if (c == 0 || it >= 2) ra = __builtin_amdgcn_mfma_f32_16x16x32_bf16(wop[c], ld_perm(SLOTP(3), oi, c, fq), ra, 0, 0, 0);
                        pa = __builtin_amdgcn_mfma_f32_16x16x32_bf16(wop[c], ld_perm(SLOTP(9), oi, c, fq), pa, 0, 0, 0); }
                    const float gci = GC[oi]; f32x4 pm = -pa;
#pragma unroll
                    for (int q = 0; q < 4; ++q) if (oj + q == oi) pm[q] += gci;
                    st_bf4(SLOTP(10) + oi * LDB + oj, bf4_f32(*(const LAS v2u*)(SLOTP(7) + oi * LDB + oj)) - ra); st_bf4(SLOTP(11) + oi * LDB + oj, pm); }
            } else {
                f32x4 u_[4] = {zf4, zf4, zf4, zf4};
#pragma unroll
                for (int jt = 0; jt < 4; ++jt)
#pragma unroll
                    for (int c = 0; c < 2; ++c) if (c == 0 || jt >= 2) u_[jt] = __builtin_amdgcn_mfma_f32_16x16x32_bf16(ld_perm(SLX, 16 * jt + fr, c, fq), gop[c], u_[jt], 0, 0, 0);
                pg8::bf16x8 uop[2]; uop[0] = pack_op(-u_[0], -u_[1]); uop[1] = pack_op(-u_[2], -u_[3]);
#pragma unroll
                for (int jt = 0; jt < 4; ++jt) {
#pragma unroll
                    for (int c = 0; c < 2; ++c) pq[jt] = __builtin_amdgcn_mfma_f32_16x16x32_bf16(ld_perm(SLOTP(9), 16 * jt + fr, c, fq), uop[c], pq[jt], 0, 0, 0);
                    st_bf4(SLOTP(12) + (16 * wq + fr) * LDB + 16 * jt + 4 * fq, pq[jt]); }
#pragma unroll
                for (int it = 0; it < 4; ++it) {
#pragma unroll
                    for (int c = 0; c < 2; ++c) if (c == 0 || it >= 2) py[it] = __builtin_amdgcn_mfma_f32_16x16x32_bf16(uop[c], ld_perm(SLOTP(3), 16 * it + fr, c, fq), py[it], 0, 0, 0);
                    st_bf4(SLOTP(13) + (16 * it + fr) * LDB + 16 * wq + 4 * fq, py[it]); }
            }
            LBAR();
            asm volatile("" : "+v"(pxw), "+v"(pxa), "+v"(pw2), "+v"(pa2));
asm volatile("" : "+v"(prr), "+v"(prk), "+v"(prv));
            asm volatile("" : "+v"(w0v), "+v"(a0v), "+v"(kkc), "+v"(kac), "+v"(rkc));
            { const int row = tid >> 3, ck = tid & 7; const size_t ub = (size_t)u * 4096 + row * 64 + ck * 8;
              *(GAS v4u*)(RHB + ub) = *(const LAS v4u*)(SLOTP(10) + row * LDB + ck * 8); *(GAS v4u*)(PMB + ub) = *(const LAS v4u*)(SLOTP(11) + row * LDB + ck * 8); *(GAS v4u*)(QTB + ub) = *(const LAS v4u*)(SLOTP(12) + row * LDB + ck * 8);
              *(GAS v4u*)(YLT + ub) = *(const LAS v4u*)(SLOTP(13) + row * LDB + ck * 8); }
#undef SLOTP
#undef OI4
#undef OJ4
#undef FOR_T4
#undef ZERO4
        }
#undef P4B_FETCH
        }
        GRID_BAR(); RELAUNDER_L;

        for (int tk = bx; tk < 256; tk += G) {
            FRESH_IDS
            const int wl = wave & 3, vt = wave >> 2, c = lane & 15, g = lane >> 4;
            const int smp = tk >> 7, tq = tk & 127, sp = (tq >> 4) * 8 + (tq & 7), vh = (tq >> 3) & 1, nch = smp ? 64 : 128,     d = (sp >> 4) & 1, h = sp & 15, cbase = seq_base((sp >> 5) + 2 * smp) >> 6;
            const int vcol = 32 * vh + 16 * vt + c;
            LAS bf16* const ZX = (LAS bf16*)(lds + RING_OFF);
            f32x4 Zc = {0.f, 0.f, 0.f, 0.f};
            struct PSet { pg8::bf16x8 O0, O1; v2u Qc; float Yl[4]; };
            PSet s0, s1, s2, s3, s4, s5, s6, s7;
            const bf16* const OWN = vt ? RHB : PMB;
            LAS v4u* const XB = (LAS v4u*)(lds + RING_OFF + 16384);
#define P4C_GEOM(kk_) const int kq_ = (kk_) < nch ? (kk_) : nch - 1; const int cc_ = cbase + (d ? nch - 1 - kq_ : kq_); \
                const size_t ub_ = ((size_t)((cc_ * 16 + h) * 2 + d)) * 4096; const size_t yb_ = ((size_t)d * NTOK + cc_ * 64) * 1024 + h * 64 + 32 * vh + 16 * vt + 4 * g; (void)ub_; (void)yb_;
#define P4C_LOAD(S_, kk_) do { P4C_GEOM(kk_) \
                S_.O0 = *(const pg8::bf16x8*)(OWN + ub_ + (16 * wl + c) * 64 + 8 * g); S_.O1 = *(const pg8::bf16x8*)(OWN + ub_ + (16 * wl + c) * 64 + 32 + 8 * g); \
                S_.Qc = *(const GAS v2u*)(QTB + ub_ + vcol * 64 + 16 * wl + 4 * g); \
                { const f32x4 yl_ = bf4_f32(*(const GAS v2u*)(YLT + ub_ + (16 * wl + c) * 64 + 32 * vh + 16 * vt + 4 * g)); S_.Yl[0] = yl_.x; S_.Yl[1] = yl_.y; S_.Yl[2] = yl_.z; S_.Yl[3] = yl_.w; } } while (0)
#define P4C_STEP(S_, kk_) do { P4C_GEOM(kk_) LAS bf16* zx = ZX + ((kk_) & 1) * (32 * LDB) + (16 * vt + c) * LDB; LAS v4u* xb = XB + ((kk_) & 1) * 1024; \
                st_bf4(zx + 16 * wl + 4 * g, Zc); \
                xb[(wave * 2 + 0) * 64 + lane] = __builtin_bit_cast(v4u, S_.O0); xb[(wave * 2 + 1) * 64 + lane] = __builtin_bit_cast(v4u, S_.O1); \
                LBAR(); \
                { const pg8::bf16x8 Zb0 = *(const LAS pg8::bf16x8*)(zx + 8 * g), Zb1 = *(const LAS pg8::bf16x8*)(zx + 32 + 8 * g); \
                    const pg8::bf16x8 X0 = __builtin_bit_cast(pg8::bf16x8, xb[((wave ^ 4) * 2 + 0) * 64 + lane]), X1 = __builtin_bit_cast(pg8::bf16x8, xb[((wave ^ 4) * 2 + 1) * 64 + lane]); \
                    const pg8::bf16x8 Pa0 = vt ? X0 : S_.O0, Pa1 = vt ? X1 : S_.O1, Ra0 = vt ? S_.O0 : X0, Ra1 = vt ? S_.O1 : X1; \
                    f32x4 ya = {S_.Yl[0], S_.Yl[1], S_.Yl[2], S_.Yl[3]}; \
                    ya = __builtin_amdgcn_mfma_f32_16x16x32_bf16(Zb0, Ra0, ya, 0, 0, 0); ya = __builtin_amdgcn_mfma_f32_16x16x32_bf16(Zb1, Ra1, ya, 0, 0, 0);     \
                    f32x4 za = bf4_f32(S_.Qc); \
                    za = __builtin_amdgcn_mfma_f32_16x16x32_bf16(Pa0, Zb0, za, 0, 0, 0); za = __builtin_amdgcn_mfma_f32_16x16x32_bf16(Pa1, Zb1, za, 0, 0, 0); \
                    Zc = za; \
                    { const int t_ = 16 * wl + c; v2u yw_; yw_.x = pk2(ya[0], ya[1]); yw_.y = pk2(ya[2], ya[3]); *(GAS v2u*)(YB + yb_ + (size_t)(d ? 63 - t_ : t_) * 1024) = yw_; } } } while (0)
            P4C_LOAD(s0, 0); P4C_LOAD(s1, 1); P4C_LOAD(s2, 2); P4C_LOAD(s3, 3); P4C_LOAD(s4, 4); P4C_LOAD(s5, 5); P4C_LOAD(s6, 6); P4C_LOAD(s7, 7);
            for (int k = 0; k < nch; k += 8) {
                P4C_STEP(s0, k);     P4C_LOAD(s0, k + 8);
                P4C_STEP(s1, k + 1); P4C_LOAD(s1, k + 9);
                P4C_STEP(s2, k + 2); P4C_LOAD(s2, k + 10);
                P4C_STEP(s3, k + 3); P4C_LOAD(s3, k + 11);
                P4C_STEP(s4, k + 4); P4C_LOAD(s4, k + 12);
                P4C_STEP(s5, k + 5); P4C_LOAD(s5, k + 13);
                P4C_STEP(s6, k + 6); P4C_LOAD(s6, k + 14);
                P4C_STEP(s7, k + 7); P4C_LOAD(s7, k + 15);
            }
#undef P4C_STEP
#undef P4C_LOAD
#undef P4C_GEOM
            LBAR();
        } }
        __syncthreads(); RELAUNDER_L;
        if (G < 256 || bx >= 128) {
            const int Gs = G >= 256 ? 128 : G, cs = G >= 256 ? bx - 128 : bx;
            pg8::Gemm g{POOLED, POOLW + (size_t)l * 1024 * 256, NTOK, 1024, 256, 1024, 256, 256}; pg8::StaticOrder S; S.init(NTOK, 1024, Gs, cs);
            pg8::EpiBf16<0> E{MIX + 1024, DM, INP(I_POOLS) + l * 1024};
            pg8::gemm_phase<pg8::EpiBf16<0>, pg8::StaticOrder, true>(lds + RING_OFF, g, S, E);
            pg8::Gemm g2_{SGX, G2TB + (size_t)l * 1024 * 256, NTOK, 1024, 256, 256, 256, 0}; pg8::StaticOrder S2_; S2_.init(NTOK, 1024, Gs, cs);
            pg8::EpiBf16<0> E2_{GATE, 1024, nullptr};
            pg8::gemm_phase<pg8::EpiBf16<0>, pg8::StaticOrder, true>(lds + RING_OFF, g2_, S2_, E2_);
        }
        GRID_BAR(); RELAUNDER_L;

        for (int rep_ = 0; rep_ < REP_P6; ++rep_) { if (rep_) { GRID_BAR(); RELAUNDER_L; }
            FRESH_IDS
            const int half = wave & 1, tsel = wave >> 1, chn = 512 * half + 8 * lane, hd = 8 * half + (lane >> 3);
            const f32x4 lw0 = *(const f32x4*)(INP(I_LNW) + l * 1024 + chn), lw1 = *(const f32x4*)(INP(I_LNW) + l * 1024 + chn + 4), lb0 = *(const f32x4*)(INP(I_LNB) + l * 1024 + chn), lb1 = *(const f32x4*)(INP(I_LNB) + l * 1024 + chn + 4);
#pragma unroll 4
            for (int m = bx * 4 + tsel; m < NTOK; m += 4 * G) {
                const v4u ya = *(const GAS v4u*)(YB + (size_t)m * 1024 + chn), yb = *(const GAS v4u*)(YB + ((size_t)NTOK + m) * 1024 + chn);
                const v4u vx = *(const GAS v4u*)(PB + (size_t)m * INCP + C_V + chn), gw = *(const GAS v4u*)(GATE + (size_t)m * 1024 + chn);
                const float bo = BON[(size_t)m * 16 + hd] + BON[((size_t)NTOK + m) * 16 + hd];
                const f32x4 y0 = bf4_f32((v2u){ya.x, ya.y}) + bf4_f32((v2u){yb.x, yb.y}), y1 = bf4_f32((v2u){ya.z, ya.w}) + bf4_f32((v2u){yb.z, yb.w});
                const float mu = red8(((y0.x + y0.y) + (y0.z + y0.w)) + ((y1.x + y1.y) + (y1.z + y1.w))) * (1.f / 64.f); const f32x4 d0 = y0 - mu, d1 = y1 - mu;
                const float var = red8(((d0.x * d0.x + d0.y * d0.y) + (d0.z * d0.z + d0.w * d0.w)) + ((d1.x * d1.x + d1.y * d1.y) + (d1.z * d1.z + d1.w * d1.w))) * (1.f / 64.f); const float rs = __builtin_amdgcn_rsqf(var + GN_EPS);
                const f32x4 o0 = (d0 * rs * lw0 + lb0 + bo * bf4_f32((v2u){vx.x, vx.y})) * bf4_f32((v2u){gw.x, gw.y}), o1 = (d1 * rs * lw1 + lb1 + bo * bf4_f32((v2u){vx.z, vx.w})) * bf4_f32((v2u){gw.z, gw.w});
                v4u w; w.x = pk2(o0.x, o0.y); w.y = pk2(o0.z, o0.w); w.z = pk2(o1.x, o1.y); w.w = pk2(o1.z, o1.w);
                *(GAS v4u*)(MIX + (size_t)m * DM + chn) = w;
            }
        }
        GRID_BAR(); RELAUNDER_L;

        { pg8::Gemm g{MIX, WOUTT + (size_t)l * DM * DM, NTOK, DM, DM, DM, DM, 0}; pg8::StaticOrder S; S.init(NTOK, DM, G, bx);
          pg8::EpiResGate E{l == 0 ? INP(I_XP) : nullptr, l == 0 ? INP(I_XS) - (size_t)16384 * DM : nullptr, XR, modl + 2 * 2048};
          pg8::gemm_phase<pg8::EpiResGate, pg8::StaticOrder, true>(lds + RING_OFF, g, S, E); }
        GRID_BAR(); RELAUNDER_L;

        NORM_PHASE_BF(INP(I_N2G) + l * DM, 3, 4);
        GRID_BAR(); RELAUNDER_L;

        for (int rep_ = 0; rep_ < REP_P9; ++rep_) { if (rep_) { GRID_BAR(); RELAUNDER_L; } pg8::Gemm g{HB, W1T + (size_t)l * DFF * DM, NTOK, DFF, DM, DM, DM, 0}; pg8::StaticOrder S; S.init(NTOK, DFF, G, bx);
          pg8::EpiBf16<1> E{F1, DFF, nullptr};
          pg8::gemm_phase<pg8::EpiBf16<1>, pg8::StaticOrder, true>(lds + RING_OFF, g, S, E); }
        GRID_BAR(); RELAUNDER_L;

        { pg8::Gemm g{F1, W2T + (size_t)l * DM * DFF, NTOK, DM, DFF, DFF, DFF, 0}; pg8::StaticOrder S; S.init(NTOK, DM, G, bx);
          pg8::EpiResGate E{nullptr, nullptr, XR, modl + 5 * 2048};
          pg8::gemm_phase<pg8::EpiResGate, pg8::StaticOrder, true>(lds + RING_OFF, g, S, E); }
        GRID_BAR(); RELAUNDER_L;
    }

    FRESH_IDS
    for (int m = gw; m < NTOK; m += NGW) { const bf16* xr = XR + (size_t)m * DM; float* orow = out + (size_t)m * DM; const float* fg = INP(I_FG);
        f32x4 v[8]; float ss = 0.f;
#pragma unroll
        for (int j = 0; j < 4; ++j) { const v4u w = *(const GAS v4u*)(xr + 8 * lane + 512 * j); v[2 * j] = bf4_f32((v2u){w.x, w.y}); v[2 * j + 1] = bf4_f32((v2u){w.z, w.w}); }
#pragma unroll
        for (int j = 0; j < 8; ++j) ss += (v[j].x * v[j].x + v[j].y * v[j].y) + (v[j].z * v[j].z + v[j].w * v[j].w);
        const float rs = 1.0f / sqrtf(wave_sum(ss) * (1.f / DM) + NORM_EPS);
#pragma unroll
        for (int j = 0; j < 4; ++j) { const int c = 8 * lane + 512 * j; *(f32x4*)(orow + c) = v[2 * j] * rs * *(const f32x4*)(fg + c); *(f32x4*)(orow + c + 4) = v[2 * j + 1] * rs * *(const f32x4*)(fg + c + 4); } }
}

extern "C" void kernel_launch(void* const* d_in, const int* in_sizes, int n_in, void* d_out, int out_size, void* d_ws, size_t ws_size, hipStream_t stream) {
    static int grid = 0;
    if (grid == 0) {
        if (n_in != 25 || out_size != NTOK * DM || ws_size < WS_END) { fprintf(stderr, "kernel_launch: unexpected shapes (n_in %d, out %d, ws %zu); nothing launched\n", n_in, out_size, ws_size); grid = -1; return; }
        int dev = 0, cus = 0, per_cu = 0;
        if (hipGetDevice(&dev) != hipSuccess || hipDeviceGetAttribute(&cus, hipDeviceAttributeMultiprocessorCount, dev) != hipSuccess) { grid = -1; return; }
        if (hipFuncSetAttribute((const void*)hymba_fwd, hipFuncAttributeMaxDynamicSharedMemorySize, LDS_BYTES) != hipSuccess) { fprintf(stderr, "kernel_launch: hipFuncSetAttribute failed\n"); grid = -1; return; }
        if (hipOccupancyMaxActiveBlocksPerMultiprocessor(&per_cu, (const void*)hymba_fwd, NWAVES * 64, LDS_BYTES) != hipSuccess || per_cu < 1) { fprintf(stderr, "kernel_launch: occupancy query reports %d\n", per_cu); }
        (void)hipGetLastError();
        grid = cus;
    }
    if (grid < 0) return;
    if (hipMemsetAsync((char*)d_ws + WS_CTL, 0, CTL_ZERO_BYTES, stream) != hipSuccess) return;
    Args a{};
    for (int i = 0; i < 25; ++i) a.in[i] = (const float*)d_in[i];
    a.out = (float*)d_out; a.ws = (unsigned char*)d_ws;
    hipLaunchKernelGGL(hymba_fwd, dim3(grid), dim3(NWAVES * 64), LDS_BYTES, stream, a);
}
```
